# Optimizing an MI355X kernel written in HIP

```python
import jax, jax.numpy as jnp
from jax import lax
import numpy as np

D_MODEL = 1024
BATCH = 32
SEQ = 2048
DEPTH = 2
DEC_BATCH = 8
DEC_SEQ = 4096
PAST_LEN = 128

A_HEADS = 4
A_V = D_MODEL // A_HEADS
A_QK = A_V // 2
B_HEADS = 4
B_V = D_MODEL // B_HEADS
B_QK = D_MODEL // B_HEADS
D_FF = ((8 * D_MODEL // 3 + 127) // 128) * 128
CONV_W = 3
CHUNK = 128
ALPHA = (2 * DEPTH) ** 0.25
BETA = (8 * DEPTH) ** -0.25
LN_EPS = 1e-5
ROPE_BASE = 10000.0

A_QK_W = A_HEADS * A_QK
A_V_W = A_HEADS * A_V
A_GATE_W = 2 * 2 * A_HEADS
B_QK_W = B_HEADS * B_QK
B_V_W = B_HEADS * B_V
SPLITS = (A_QK_W, A_QK_W, A_V_W, A_V_W, A_GATE_W, B_QK_W, B_QK_W, B_V_W, B_V_W, D_MODEL, D_MODEL)
N_IN = sum(SPLITS)

kernel_name = "hybrid_mlstm_retention_encoder"


def layer_norm(x, g, b):
    xf = x.astype(jnp.float32)
    mu = jnp.mean(xf, -1, keepdims=True)
    var = jnp.mean(jnp.square(xf - mu), -1, keepdims=True)
    return ((xf - mu) * lax.rsqrt(var + LN_EPS)).astype(x.dtype) * g + b


def head_norm(h, g, out_dtype):
    hf = h.astype(jnp.float32)
    mu = jnp.mean(hf, -1, keepdims=True)
    var = jnp.mean(jnp.square(hf - mu), -1, keepdims=True)
    y = (hf - mu) * lax.rsqrt(var + LN_EPS)
    return y.reshape(h.shape[0], h.shape[1], -1).astype(out_dtype) * g


def split_cols(u):
    idx = [int(v) for v in np.cumsum(SPLITS)[:-1]]
    return jnp.split(u, idx, axis=-1)


def to_heads(a, n_heads):
    b, s, _ = a.shape
    return a.reshape(b, s, n_heads, -1).transpose(0, 2, 1, 3)


def rope(t, cos, sin):
    c = cos[:, None, :]
    s = sin[:, None, :]
    t1, t2 = jnp.split(t, 2, axis=-1)
    return jnp.concatenate([t1 * c - t2 * s, t1 * s + t2 * c], axis=-1)


def to_chunks(a):
    b, h, s = a.shape[:3]
    return jnp.moveaxis(a.reshape(b, h, s // CHUNK, CHUNK, *a.shape[3:]), 2, 0)


def from_chunks(a):
    n, b, h, l, d = a.shape
    return jnp.moveaxis(a, 0, 2).reshape(b, h, n * l, d)


def mlstm_chunkwise(q, k, v, i_pre, logf):
    b, h, _, dk = q.shape
    dv = v.shape[-1]
    tri = jnp.tril(jnp.ones((CHUNK, CHUNK), dtype=bool))

    def step(carry, xs):
        C, nv, m = carry
        qb, kb, vb, ib, fb = xs
        cb = jnp.cumsum(fb, axis=-1)
        dmat = jnp.where(tri, cb[..., :, None] - cb[..., None, :] + ib[..., None, :], -jnp.inf)
        inter = cb + m[..., None]
        m_t = jnp.maximum(inter, jnp.max(dmat, axis=-1))
        w_inter = jnp.exp(inter - m_t)
        p = jnp.einsum('bhtd,bhsd->bhts', qb, kb) * jnp.exp(dmat - m_t[..., None])
        num = jnp.einsum('bhts,bhsv->bhtv', p, vb) + w_inter[..., None] * jnp.einsum('bhtd,bhdv->bhtv', qb, C)
        den = jnp.sum(p, axis=-1) + w_inter * jnp.einsum('bhtd,bhd->bht', qb, nv)
        h_out = num / jnp.maximum(jnp.abs(den), jnp.exp(-m_t))[..., None]
        c_last = cb[..., -1]
        g_s = c_last[..., None] - cb + ib
        m_new = jnp.maximum(c_last + m, jnp.max(g_s, axis=-1))
        w_s = jnp.exp(g_s - m_new[..., None])
        dec = jnp.exp(c_last + m - m_new)
        kw = kb * w_s[..., None]
        C = dec[..., None, None] * C + jnp.einsum('bhsd,bhsv->bhdv', kw, vb)
        nv = dec[..., None] * nv + jnp.sum(kw, axis=2)
        return (C, nv, m_new), h_out

    init = (jnp.zeros((b, h, dk, dv), jnp.float32), jnp.zeros((b, h, dk), jnp.float32),
            jnp.zeros((b, h), jnp.float32))
    _, hs = lax.scan(step, init, (to_chunks(q), to_chunks(k), to_chunks(v), to_chunks(i_pre), to_chunks(logf)))
    return from_chunks(hs)


def retention_chunkwise(q, k, v, lg):
    b, h, _, dk = q.shape
    dv = v.shape[-1]
    pos = jnp.arange(CHUNK, dtype=jnp.float32)
    diff = pos[:, None] - pos[None, :]
    dmat = jnp.where(diff >= 0, jnp.exp(lg[:, None, None] * jnp.maximum(diff, 0.0)), 0.0)
    w_inter = jnp.exp(lg[:, None] * (pos + 1.0))
    w_state = jnp.exp(lg[:, None] * (CHUNK - 1.0 - pos))
    chunk_dec = jnp.exp(lg * CHUNK)

    def step(R, xs):
        qb, kb, vb = xs
        a = jnp.einsum('bhtd,bhsd->bhts', qb, kb) * dmat
        o = jnp.einsum('bhts,bhsv->bhtv', a, vb) + w_inter[..., None] * jnp.einsum('bhtd,bhdv->bhtv', qb, R)
        R = chunk_dec[:, None, None] * R + jnp.einsum('bhsd,bhsv->bhdv', kb * w_state[..., None], vb)
        return R, o

    init = jnp.zeros((b, h, dk, dv), jnp.float32)
    _, os_ = lax.scan(step, init, (to_chunks(q), to_chunks(k), to_chunks(v)))
    return from_chunks(os_)


def flip_s(a):
    return jnp.flip(a, axis=2)


def encoder_layer(x, cos, sin, w_in, b_if, lg, g_a, g_b, w_o, ln1_g, ln1_b,
                  w_up, conv_w, conv_b, w_down, ln2_g, ln2_b):
    bsz, s, _ = x.shape
    dt = x.dtype
    u = jnp.einsum('bsd,dn->bsn', x, w_in)
    qa, ka, va, oa, gif, qb, kb, vb, gb, m_a, m_b = split_cols(u)

    qa = to_heads(qa, A_HEADS) * (A_QK ** -0.5)
    ka = to_heads(ka, A_HEADS)
    va = to_heads(va, A_HEADS)
    gif = gif.astype(jnp.float32).reshape(bsz, s, 2, 2, A_HEADS) + b_if.astype(jnp.float32)
    i_pre = jnp.transpose(gif[:, :, :, 0, :], (2, 0, 3, 1))
    logf = jnp.transpose(jax.nn.log_sigmoid(gif[:, :, :, 1, :]), (2, 0, 3, 1))
    h_f = mlstm_chunkwise(qa, ka, va, i_pre[0], logf[0])
    h_bw = flip_s(mlstm_chunkwise(flip_s(qa), flip_s(ka), flip_s(va), flip_s(i_pre[1]), flip_s(logf[1])))
    h_a = (h_f + h_bw).transpose(0, 2, 1, 3)
    h_a = h_a * jax.nn.sigmoid(oa.astype(jnp.float32)).reshape(bsz, s, A_HEADS, A_V)
    y_a = head_norm(h_a, g_a, dt)

    qb = rope(qb.reshape(bsz, s, B_HEADS, B_QK), cos, sin).transpose(0, 2, 1, 3)
    kb = (rope(kb.reshape(bsz, s, B_HEADS, B_QK), cos, sin) * (B_QK ** -0.5)).transpose(0, 2, 1, 3)
    vb = to_heads(vb, B_HEADS)
    lg = lg.astype(jnp.float32)
    r_f = retention_chunkwise(qb, kb, vb, lg[0])
    r_bw = flip_s(retention_chunkwise(flip_s(qb), flip_s(kb), flip_s(vb), lg[1]))
    y_b = head_norm((r_f + r_bw).transpose(0, 2, 1, 3), g_b, dt) * jax.nn.silu(gb)

    merged = jax.nn.sigmoid(m_a) * y_a + jax.nn.sigmoid(m_b) * y_b
    x = layer_norm(ALPHA * x + jnp.einsum('bsd,de->bse', merged, w_o), ln1_g, ln1_b)

    hu = jnp.einsum('bsd,df->bsf', x, w_up)
    hp = jnp.pad(hu, ((0, 0), (1, 1), (0, 0)))
    hc = conv_w[0] * hp[:, :-2] + conv_w[1] * hp[:, 1:-1] + conv_w[2] * hp[:, 2:] + conv_b
    val, gate = jnp.split(hc, 2, axis=-1)
    f = jax.nn.gelu(gate) * val
    x = layer_norm(ALPHA * x + jnp.einsum('bsf,fd->bsd', f, w_down), ln2_g, ln2_b)
    return x


def trunk(x, ln_in_g, ln_in_b, w_in, b_if, ret_log_decay, mlstm_norm_g, ret_norm_g, w_o,
          ln1_g, ln1_b, w_up, conv_w, conv_b, w_down, ln2_g, ln2_b):
    s = x.shape[1]
    inv_freq = ROPE_BASE ** (-jnp.arange(0, B_QK, 2, dtype=jnp.float32) / B_QK)
    ang = jnp.arange(s, dtype=jnp.float32)[:, None] * inv_freq[None, :]
    cos = jnp.cos(ang).astype(x.dtype)
    sin = jnp.sin(ang).astype(x.dtype)
    x = layer_norm(x, ln_in_g, ln_in_b)
    for l in range(DEPTH):
        x = encoder_layer(x, cos, sin, w_in[l], b_if[l], ret_log_decay[l], mlstm_norm_g[l], ret_norm_g[l],
                          w_o[l], ln1_g[l], ln1_b[l], w_up[l], conv_w[l], conv_b[l], w_down[l],
                          ln2_g[l], ln2_b[l])
    return x


def setup_inputs(seed: int = 0) -> dict:
    key = jax.random.key(seed)
    ks = jax.random.split(key, 24)
    f32 = jnp.float32

    def nrm(k, shape, scale):
        return jax.random.normal(k, shape, f32) * scale

    x_prompt = nrm(ks[0], (BATCH, SEQ, D_MODEL), 1.0)
    x_sample = nrm(ks[1], (DEC_BATCH, DEC_SEQ, D_MODEL), 1.0)
    ln_in_g = 1.0 + nrm(ks[2], (D_MODEL,), 0.02)
    ln_in_b = nrm(ks[3], (D_MODEL,), 0.02)
    w_in = nrm(ks[4], (DEPTH, D_MODEL, N_IN), D_MODEL ** -0.5)
    i_bias = nrm(ks[5], (DEPTH, 2, A_HEADS), 0.1)
    f_bias = jnp.linspace(3.0, 6.0, A_HEADS, dtype=f32) + nrm(ks[6], (DEPTH, 2, A_HEADS), 0.1)
    b_if = jnp.stack([i_bias, f_bias], axis=2)
    base = jnp.log1p(-(2.0 ** (-5.0 - jnp.arange(B_HEADS, dtype=f32))))
    ret_log_decay = base * jnp.exp(nrm(ks[7], (DEPTH, 2, B_HEADS), 0.1))
    mlstm_norm_g = 1.0 + nrm(ks[8], (DEPTH, A_V_W), 0.02)
    ret_norm_g = 1.0 + nrm(ks[9], (DEPTH, B_V_W), 0.02)
    w_o = nrm(ks[10], (DEPTH, D_MODEL, D_MODEL), BETA * D_MODEL ** -0.5)
    ln1_g = 1.0 + nrm(ks[11], (DEPTH, D_MODEL), 0.02)
    ln1_b = nrm(ks[12], (DEPTH, D_MODEL), 0.02)
    w_up = nrm(ks[13], (DEPTH, D_MODEL, 2 * D_FF), D_MODEL ** -0.5)
    conv_w = nrm(ks[14], (DEPTH, CONV_W, 2 * D_FF), CONV_W ** -0.5)
    conv_b = nrm(ks[15], (DEPTH, 2 * D_FF), 0.02)
    w_down = nrm(ks[16], (DEPTH, D_FF, D_MODEL), BETA * D_FF ** -0.5)
    ln2_g = 1.0 + nrm(ks[17], (DEPTH, D_MODEL), 0.02)
    ln2_b = nrm(ks[18], (DEPTH, D_MODEL), 0.02)
    return {"x_prompt": x_prompt, "x_sample": x_sample, "ln_in_g": ln_in_g, "ln_in_b": ln_in_b,
            "w_in": w_in, "b_if": b_if, "ret_log_decay": ret_log_decay, "mlstm_norm_g": mlstm_norm_g,
            "ret_norm_g": ret_norm_g, "w_o": w_o, "ln1_g": ln1_g, "ln1_b": ln1_b, "w_up": w_up,
            "conv_w": conv_w, "conv_b": conv_b, "w_down": w_down, "ln2_g": ln2_g, "ln2_b": ln2_b}


def reference(x_prompt, x_sample, ln_in_g, ln_in_b, w_in, b_if, ret_log_decay, mlstm_norm_g, ret_norm_g,
              w_o, ln1_g, ln1_b, w_up, conv_w, conv_b, w_down, ln2_g, ln2_b):
    y_prompt = trunk(x_prompt, ln_in_g, ln_in_b, w_in, b_if, ret_log_decay, mlstm_norm_g, ret_norm_g, w_o,
                     ln1_g, ln1_b, w_up, conv_w, conv_b, w_down, ln2_g, ln2_b)
    y_sample = trunk(x_sample, ln_in_g, ln_in_b, w_in, b_if, ret_log_decay, mlstm_norm_g, ret_norm_g, w_o,
                     ln1_g, ln1_b, w_up, conv_w, conv_b, w_down, ln2_g, ln2_b)
    return (y_prompt, y_sample)
```

```cpp
#include <hip/hip_runtime.h>
#include <hip/hip_cooperative_groups.h>
#include <cstdio>
namespace cg = cooperative_groups;

#define LAS __attribute__((address_space(3)))
#define DI __device__ __forceinline__
typedef unsigned short bf16_t;
typedef short bf16x8 __attribute__((ext_vector_type(8)));
typedef float f32x4 __attribute__((ext_vector_type(4)));
typedef float f32x16 __attribute__((ext_vector_type(16)));
typedef unsigned u32x4 __attribute__((ext_vector_type(4)));
typedef unsigned u32x2 __attribute__((ext_vector_type(2)));

constexpr int DM = 1024, NIN = 9232, DFF = 2816, NUP = 5632;
constexpr int NNORM = 7168, NTR = 2048, NW = NNORM + NTR;
constexpr int TTOT = 98304, TPROMPT = 65536;
constexpr int LDS_BYTES = 151552 + 16;
constexpr float ALPHA = 1.41421356237f;
constexpr float LN_EPS = 1e-5f;

struct KArgs {
    const float* in[18];
    float* out; char* ws; unsigned* bar;
    int G; int pad;
};
struct Params {
    const float* x_prompt; const float* x_sample; const float* ln_in_g; const float* ln_in_b; const float* w_in; const float* b_if;
    const float* lg; const float* g_a; const float* g_b; const float* w_o; const float* ln1_g; const float* ln1_b; const float* w_up;
    const float* conv_w; const float* conv_b; const float* w_down; const float* ln2_g; const float* ln2_b;
    float* out;
    bf16_t* WinT; bf16_t* WoT; bf16_t* WupT; bf16_t* WdT;
    float* cosT; float* sinT; float* cosTT; float* sinTT;
    float* gates; float* gpre; bf16_t* WgT;
    bf16_t* Qb; bf16_t* Kb; bf16_t* Qa; bf16_t* Ka; bf16_t* E; bf16_t* KbT; bf16_t* KaT; bf16_t* VaT; bf16_t* VbT;
    bf16_t* H0; bf16_t* H1; bf16_t* H2; bf16_t* H3;
    bf16_t* xb; bf16_t* merged; bf16_t* hu; bf16_t* ff;
    int G; int pad;
};

typedef float f32x2 __attribute__((ext_vector_type(2)));
typedef __bf16 bf16v2 __attribute__((ext_vector_type(2)));
DI unsigned f2bf(float x) { unsigned u = __float_as_uint(x); u += 0x7fffu + ((u >> 16) & 1u); return u >> 16; }
DI unsigned pk2(float lo, float hi) { const f32x2 v = {lo, hi}; return __builtin_bit_cast(unsigned, __builtin_convertvector(v, bf16v2)); }
DI float bflo(unsigned w) { return __uint_as_float(w << 16); }
DI float bfhi(unsigned w) { return __uint_as_float(w & 0xffff0000u); }
DI float frcp(float x) { return __builtin_amdgcn_rcpf(x); }
DI float sigmoidf_(float x) { return frcp(1.f + __expf(-x)); }
#define MFMA32(a, b, c) __builtin_amdgcn_mfma_f32_32x32x16_bf16((a), (b), (c), 0, 0, 0)

namespace pg8 {
constexpr int BM = 256, BK = 64, HALF = 128, HTB = HALF * BK * 2, STAGE_BYTES = 8 * HTB, NXCD = 8, WGM = 8;
DI int lds_byte(int r, int c) { const int st = (r >> 4) * 2 + (c >> 5), rr = r & 15, cc = c & 31, ob = rr * 64 + cc * 2; return st * 1024 + (ob ^ (((ob >> 9) & 1) << 5)); }
DI void stage_rc(int b, int& R, int& C) { const int st = b / 1024, sb = b % 1024, swz = sb ^ (((sb >> 9) & 1) << 5); R = (st >> 1) * 16 + swz / 64; C = (st & 1) * 32 + (swz % 64) / 2; }
DI int perm32(int rho) { const int n = rho >> 4, i = rho & 15; return 8 * (i >> 2) + 4 * n + (i & 3); }
struct Unit { int pm, pn; };
struct Gemm { const bf16_t* A; const bf16_t* Bt; int M, N, K; };
struct StaticOrder {
    int nM, nN, nwg, G, c;
    DI void init(int M, int N, int G_, int c_) { nM = M / BM; nN = N / BM; nwg = nM * nN; G = G_; c = c_; }
    DI bool next(int i, Unit& u) const {
        const long L = (long)i * G + c; if (L >= nwg) return false;
        int wgid = (int)L; { const int q = nwg / NXCD, r = nwg % NXCD, xcd = wgid % NXCD, off = wgid / NXCD; wgid = (xcd < r ? xcd * (q + 1) : r * (q + 1) + (xcd - r) * q) + off; }
        const int nig = WGM * nN, gid = wgid / nig, fm = gid * WGM, gsz = (nM - fm) < WGM ? (nM - fm) : WGM;
        u.pm = fm + ((wgid % nig) % gsz); u.pn = (wgid % nig) / gsz; return true;
    }
};

template <class Epi>
DI void gemm_phase(LAS unsigned char* lds, const Gemm g, const StaticOrder& S, const Epi& E, const int tid) {
    const int wid = __builtin_amdgcn_readfirstlane(tid >> 6), lane = tid & 63, wr = wid >> 2, wc = wid & 3, fr = lane & 15, fq = lane >> 4;
    const int K = g.K, nt = K / BK;
    unsigned voffA[2], voffB[2];
#pragma unroll
    for (int i = 0; i < 2; ++i) { int R, C; stage_rc(tid * 16 + i * 8192, R, C); const int Rb = Epi::PERM ? ((R & ~31) + perm32(R & 31)) : R;
        voffA[i] = (unsigned)(R * K + C) * 2u; voffB[i] = (unsigned)(Rb * K + C) * 2u; }
    const size_t kstep = (size_t)(BK * 2);
    const size_t hstep = (size_t)HALF * K * 2;
    const size_t tstep = 2 * hstep;
    const unsigned ldsw = (unsigned)wid * 1024u;
    const int aoff = lds_byte(wr * 64 + fr, fq * 8), boff = lds_byte(wc * 32 + fr, fq * 8);
#define PG8_SA(b, h) (((b) * 2 + (h)) * HTB)
#define PG8_SB(b, h) ((4 + (b) * 2 + (h)) * HTB)
#define PG8_STAGE(bufoff, gbase, voff) do { _Pragma("unroll") for (int _i = 0; _i < 2; ++_i) \
        __builtin_amdgcn_global_load_lds((const unsigned*)((const char*)(gbase) + (voff)[_i]), (LAS unsigned*)(lds + (bufoff) + ldsw + _i * 8192), 16, 0, 0); } while (0)
#define PG8_LDA(dst, b, h) do { _Pragma("unroll") for (int m = 0; m < 4; ++m) _Pragma("unroll") for (int k = 0; k < 2; ++k) dst[m][k] = *(const LAS bf16x8*)(lds + PG8_SA(b, h) + aoff + m * 2048 + k * 1024); } while (0)
#define PG8_LDB(dst, b, h) do { _Pragma("unroll") for (int n = 0; n < 2; ++n) _Pragma("unroll") for (int k = 0; k < 2; ++k) dst[n][k] = *(const LAS bf16x8*)(lds + PG8_SB(b, h) + boff + n * 2048 + k * 1024); } while (0)
#define PG8_MMA(ai, bj, At, Bt) do { __builtin_amdgcn_s_setprio(1); _Pragma("unroll") for (int m = 0; m < 4; ++m) _Pragma("unroll") for (int n = 0; n < 2; ++n) _Pragma("unroll") for (int k = 0; k < 2; ++k) \
        acc[ai][bj][m][n] = __builtin_amdgcn_mfma_f32_16x16x32_bf16(Bt[n][k], At[m][k], acc[ai][bj][m][n], 0, 0, 0); __builtin_amdgcn_s_setprio(0); } while (0)
#define PG8_WAIT_V(n) asm volatile("s_waitcnt vmcnt(" #n ")" ::: "memory")
#define PG8_WAIT_L(n) asm volatile("s_waitcnt lgkmcnt(" #n ")" ::: "memory")
#define PG8_BAR __builtin_amdgcn_s_barrier()
#define PG8_SCHED __builtin_amdgcn_sched_barrier(0)
    Unit cur, nxt; int ui = 0;
    if (!S.next(0, cur)) return;
    f32x4 acc[2][2][4][2];
#pragma unroll
    for (int a = 0; a < 2; ++a)
#pragma unroll
        for (int b = 0; b < 2; ++b)
#pragma unroll
            for (int m = 0; m < 4; ++m)
#pragma unroll
                for (int n = 0; n < 2; ++n) acc[a][b][m][n] = (f32x4){0.f, 0.f, 0.f, 0.f};
    bf16x8 At[4][2], B0[2][2], B1[2][2];
    const char* cA = (const char*)g.A + (size_t)cur.pm * tstep; const char* cB = (const char*)g.Bt + (size_t)cur.pn * tstep;
    PG8_STAGE(PG8_SB(0, 0), cB, voffB); PG8_STAGE(PG8_SA(0, 0), cA, voffA); PG8_STAGE(PG8_SB(0, 1), cB + hstep, voffB); PG8_STAGE(PG8_SA(0, 1), cA + hstep, voffA);
    if (wr == 1) PG8_BAR;
    PG8_WAIT_V(4); PG8_BAR;
    PG8_STAGE(PG8_SB(1, 0), cB + kstep, voffB); PG8_STAGE(PG8_SA(1, 0), cA + kstep, voffA); PG8_STAGE(PG8_SB(1, 1), cB + hstep + kstep, voffB);
    PG8_WAIT_V(6); PG8_BAR;
    for (;;) {
        const bool has_next = S.next(ui + 1, nxt);
        const char* nA = has_next ? (const char*)g.A + (size_t)nxt.pm * tstep : cA; const char* nB = has_next ? (const char*)g.Bt + (size_t)nxt.pn * tstep : cB;
        for (int t = 0; t < nt; t += 2) {
            const bool last = (t == nt - 2);
            const char* a1 = cA + (size_t)(t + 1) * kstep;
            const char* a2 = last ? nA : cA + (size_t)(t + 2) * kstep; const char* b2 = last ? nB : cB + (size_t)(t + 2) * kstep;
            const char* a3 = a2 + kstep; const char* b3 = b2 + kstep;
            PG8_LDB(B0, 0, 0); PG8_SCHED; PG8_LDA(At, 0, 0); PG8_STAGE(PG8_SA(1, 1), a1 + hstep, voffA);
            PG8_WAIT_L(8); PG8_BAR; PG8_WAIT_L(0); PG8_MMA(0, 0, At, B0); PG8_BAR; PG8_SCHED;
            PG8_LDB(B1, 0, 1); PG8_STAGE(PG8_SB(0, 0), b2, voffB);
            PG8_BAR; PG8_WAIT_L(0); PG8_MMA(0, 1, At, B1); PG8_BAR;
            PG8_LDA(At, 0, 1); PG8_STAGE(PG8_SA(0, 0), a2, voffA);
            PG8_BAR; PG8_WAIT_L(0); PG8_MMA(1, 0, At, B0); PG8_BAR; PG8_SCHED;
            PG8_STAGE(PG8_SB(0, 1), b2 + hstep, voffB);
            PG8_WAIT_V(6); PG8_BAR; PG8_MMA(1, 1, At, B1); PG8_BAR;
            PG8_LDB(B0, 1, 0); PG8_SCHED; PG8_LDA(At, 1, 0); PG8_STAGE(PG8_SA(0, 1), a2 + hstep, voffA);
            PG8_WAIT_L(8); PG8_BAR; PG8_WAIT_L(0); PG8_MMA(0, 0, At, B0); PG8_BAR; PG8_SCHED;
            PG8_LDB(B1, 1, 1); PG8_STAGE(PG8_SB(1, 0), b3, voffB);
            PG8_BAR; PG8_WAIT_L(0); PG8_MMA(0, 1, At, B1); PG8_BAR;
            PG8_LDA(At, 1, 1); PG8_STAGE(PG8_SA(1, 0), a3, voffA);
            PG8_BAR; PG8_WAIT_L(0); PG8_MMA(1, 0, At, B0); PG8_BAR; PG8_SCHED;
            PG8_STAGE(PG8_SB(1, 1), b3 + hstep, voffB);
            PG8_WAIT_V(6); PG8_BAR; PG8_MMA(1, 1, At, B1); PG8_BAR;
        }
        { int fr2 = fr, fq2 = fq; asm volatile("" : "+v"(fr2), "+v"(fq2)); E(acc, cur, wr, wc, fr2, fq2); }
        if (!has_next) break;
#pragma unroll
        for (int a = 0; a < 2; ++a)
#pragma unroll
            for (int b = 0; b < 2; ++b)
#pragma unroll
                for (int m = 0; m < 4; ++m)
#pragma unroll
                    for (int n = 0; n < 2; ++n) acc[a][b][m][n] = (f32x4){0.f, 0.f, 0.f, 0.f};
        cur = nxt; cA = nA; cB = nB; ++ui;
    }
    PG8_WAIT_V(0);
    if (wr == 0) PG8_BAR;
    PG8_BAR;
#undef PG8_SA
#undef PG8_SB
#undef PG8_STAGE
#undef PG8_LDA
#undef PG8_LDB
#undef PG8_MMA
#undef PG8_WAIT_V
#undef PG8_WAIT_L
#undef PG8_BAR
#undef PG8_SCHED
}
}

typedef f32x4 AccT[2][2][4][2];
DI u32x4 pack8(f32x4 a, f32x4 b) { u32x4 w; w.x = pk2(a[0], a[1]); w.y = pk2(a[2], a[3]); w.z = pk2(b[0], b[1]); w.w = pk2(b[2], b[3]); return w; }
DI size_t fragoff(int row, int kidx, int KS) { return (size_t)((((row >> 5) * KS + (kidx >> 4)) * 64 + (row & 31) + 32 * ((kidx >> 3) & 1)) * 8); }

DI void kt_store(unsigned char* sc, const u32x4 w, int fr, int fq, bf16_t* ktbase, int dbase, int sbase) {
    unsigned short* s16 = (unsigned short*)sc;
#pragma unroll
    for (int j = 0; j < 8; ++j) s16[(8 * fq + j) * 24 + fr] = (unsigned short)((w[j >> 1] >> (16 * (j & 1))) & 0xffffu);
    asm volatile("s_waitcnt lgkmcnt(0)" ::: "memory");
    const int L = fr + 16 * fq, fl = L >> 1, th = L & 1;
    const u32x4 r = *(const u32x4*)(sc + (fl * 24 + th * 8) * 2);
    asm volatile("s_waitcnt lgkmcnt(0)" ::: "memory");
    *(u32x4*)(ktbase + fragoff(dbase + fl, sbase + th * 8, 8)) = r;
}
struct EpiInN {
    static constexpr bool PERM = true;
    const Params* p; int S; unsigned char* smem;
    DI void operator()(const AccT& acc, const pg8::Unit& u, int wr, int wc, int fr, int fq) const {
        const int pn = u.pn;
        const int d0 = wc * 32 + 8 * fq;
        if (pn < 8) {
            bf16_t* dst = pn < 4 ? p->Qb : p->Kb; const int head = pn & 3;
#pragma unroll
            for (int ai = 0; ai < 2; ++ai)
#pragma unroll
                for (int m = 0; m < 4; ++m) {
                    const int row = u.pm * 256 + ai * 128 + wr * 64 + m * 16 + fr; const int pos = row % S; const int chunk = row >> 7, t = row & 127;
                    const f32x4 c0 = *(const f32x4*)(p->cosT + pos * 128 + d0), c1 = *(const f32x4*)(p->cosT + pos * 128 + d0 + 4);
                    const f32x4 s0 = *(const f32x4*)(p->sinT + pos * 128 + d0), s1 = *(const f32x4*)(p->sinT + pos * 128 + d0 + 4);
                    const f32x4 x10 = acc[ai][0][m][0], x11 = acc[ai][0][m][1], x20 = acc[ai][1][m][0], x21 = acc[ai][1][m][1];
                    const f32x4 o10 = x10 * c0 - x20 * s0, o11 = x11 * c1 - x21 * s1, o20 = x10 * s0 + x20 * c0, o21 = x11 * s1 + x21 * c1;
                    bf16_t* base = dst + (size_t)(chunk * 4 + head) * (128 * 256);
                    const u32x4 w1 = pack8(o10, o11), w2 = pack8(o20, o21);
                    *(u32x4*)(base + fragoff(t, d0, 16)) = w1;
                    *(u32x4*)(base + fragoff(t, d0 + 128, 16)) = w2;
                    if (pn >= 4) {
                        unsigned char* sc = smem + 131072 + (wr * 4 + wc) * 2048;
                        bf16_t* ktb = p->KbT + (size_t)(chunk * 4 + head) * (256 * 128);
                        kt_store(sc, w1, fr, fq, ktb, wc * 32, wr * 64 + m * 16);
                        kt_store(sc, w2, fr, fq, ktb, 128 + wc * 32, wr * 64 + m * 16);
                    }
                }
        } else if (pn < 12) {
            bf16_t* dst = pn < 10 ? p->Qa : p->Ka;
#pragma unroll
            for (int ai = 0; ai < 2; ++ai)
#pragma unroll
                for (int m = 0; m < 4; ++m) {
                    const int row = u.pm * 256 + ai * 128 + wr * 64 + m * 16 + fr; const int chunk = row >> 7, t = row & 127;
#pragma unroll
                    for (int bj = 0; bj < 2; ++bj) {
                        const int head = ((pn - 8) & 1) * 2 + bj;
                        bf16_t* base = dst + (size_t)(chunk * 4 + head) * (128 * 128);
                        const u32x4 w1 = pack8(acc[ai][bj][m][0], acc[ai][bj][m][1]);
                        *(u32x4*)(base + fragoff(t, d0, 8)) = w1;
                        if (pn >= 10) kt_store(smem + 131072 + (wr * 4 + wc) * 2048, w1, fr, fq, p->KaT + (size_t)(chunk * 4 + head) * (128 * 128), wc * 32, wr * 64 + m * 16);
                    }
                }
        } else {
#pragma unroll
            for (int ai = 0; ai < 2; ++ai)
#pragma unroll
                for (int m = 0; m < 4; ++m) {
                    const int row = u.pm * 256 + ai * 128 + wr * 64 + m * 16 + fr;
                    bf16_t* rp = p->E + (size_t)row * 4096 + (pn - 12) * 256 + d0;
#pragma unroll
                    for (int bj = 0; bj < 2; ++bj) *(u32x4*)(rp + bj * 128) = pack8(acc[ai][bj][m][0], acc[ai][bj][m][1]);
                }
        }
    }
};
struct EpiInT {
    static constexpr bool PERM = true;
    const Params* p; int S;
    DI void operator()(const AccT& acc, const pg8::Unit& u, int wr, int wc, int fr, int fq) const {
        const int pm = u.pm;
        const int s0 = wc * 32 + 8 * fq;
        bf16_t* dst = pm < 4 ? p->VaT : p->VbT; const int head = pm & 3;
#pragma unroll
        for (int ai = 0; ai < 2; ++ai)
#pragma unroll
            for (int bj = 0; bj < 2; ++bj) {
                const int chunk = u.pn * 2 + bj;
                bf16_t* base = dst + (size_t)(chunk * 4 + head) * (256 * 128);
#pragma unroll
                for (int m = 0; m < 4; ++m) { const int v = ai * 128 + wr * 64 + m * 16 + fr; *(u32x4*)(base + fragoff(v, s0, 8)) = pack8(acc[ai][bj][m][0], acc[ai][bj][m][1]); }
            }
    }
};
template <bool XB> struct EpiRes {
    static constexpr bool PERM = false;
    float* Y;
    const bf16_t* X;
    DI void operator()(const AccT& acc, const pg8::Unit& u, int wr, int wc, int fr, int fq) const {
        const int row0 = u.pm * 256 + wr * 64 + fr, col0 = u.pn * 256 + wc * 32 + 4 * fq;
#pragma unroll
        for (int ai = 0; ai < 2; ++ai) {
            f32x4 xv[4][2][2];
#pragma unroll
            for (int m = 0; m < 4; ++m)
#pragma unroll
                for (int bj = 0; bj < 2; ++bj)
#pragma unroll
                    for (int n = 0; n < 2; ++n) {
                        const size_t off = (size_t)(row0 + ai * 128 + m * 16) * DM + col0 + bj * 128 + n * 16;
                        if (XB) { const u32x2 xw = *(const u32x2*)(X + off); xv[m][bj][n] = (f32x4){bflo(xw.x), bfhi(xw.x), bflo(xw.y), bfhi(xw.y)}; }
                        else xv[m][bj][n] = *(const f32x4*)(Y + off);
                    }
#pragma unroll
            for (int m = 0; m < 4; ++m)
#pragma unroll
                for (int bj = 0; bj < 2; ++bj)
#pragma unroll
                    for (int n = 0; n < 2; ++n) {
                        const size_t off = (size_t)(row0 + ai * 128 + m * 16) * DM + col0 + bj * 128 + n * 16;
                        *(f32x4*)(Y + off) = xv[m][bj][n] * ALPHA + acc[ai][bj][m][n];
                    }
        }
    }
};
struct EpiB16 {
    static constexpr bool PERM = true;
    bf16_t* O; int ldc;
    DI void operator()(const AccT& acc, const pg8::Unit& u, int wr, int wc, int fr, int fq) const {
        const int row0 = u.pm * 256 + wr * 64 + fr, col0 = u.pn * 256 + wc * 32 + 8 * fq;
#pragma unroll
        for (int ai = 0; ai < 2; ++ai)
#pragma unroll
            for (int m = 0; m < 4; ++m) { bf16_t* rp = O + (size_t)(row0 + ai * 128 + m * 16) * ldc + col0;
#pragma unroll
                for (int bj = 0; bj < 2; ++bj) *(u32x4*)(rp + bj * 128) = pack8(acc[ai][bj][m][0], acc[ai][bj][m][1]); }
    }
};

DI void transpose_cvt(const float* W, bf16_t* WT, int K, int N, int tid) {
    const long total = (long)N * (K / 8);
    for (long i = (long)blockIdx.x * 512 + tid; i < total; i += (long)gridDim.x * 512) {
        const int n = (int)(i % N), kc = (int)(i / N);
        const float* w = W + (size_t)(kc * 8) * N + n;
        float v[8];
#pragma unroll
        for (int j = 0; j < 8; ++j) v[j] = w[(size_t)j * N];
        u32x4 o; o.x = pk2(v[0], v[1]); o.y = pk2(v[2], v[3]); o.z = pk2(v[4], v[5]); o.w = pk2(v[6], v[7]);
        *(u32x4*)(WT + (size_t)n * K + kc * 8) = o;
    }
}
DI void phase_prep(const Params& p, int tid) {
    const long gtid = (long)blockIdx.x * 512 + tid, gsz = (long)gridDim.x * 512;
    for (long i = gtid; i < 2L * NW * 128; i += gsz) {
        const int n = (int)(i % NW), kc = (int)((i / NW) % 128), l = (int)(i / ((long)NW * 128));
        int src; float sc = 1.f;
        if (n < NNORM) {
            if (n < 1024) src = 3088 + n;
            else if (n < 2048) { src = 4112 + (n - 1024); sc = 0.0625f; }
            else if (n < 2560) { src = n - 2048; sc = 0.08838834764831845f; }
            else if (n < 3072) src = 512 + (n - 2560);
            else if (n < 4096) src = 2048 + (n - 3072);
            else if (n < 5120) src = 6160 + (n - 4096);
            else if (n < 6144) src = 7184 + (n - 5120);
            else src = 8208 + (n - 6144);
        } else {
            const int m = n - NNORM;
            if (m < 1024) src = 1024 + m;
            else src = 5136 + (m - 1024);
        }
        const float* w = p.w_in + (size_t)l * DM * NIN + (size_t)(kc * 8) * NIN + src;
        float v[8];
#pragma unroll
        for (int j = 0; j < 8; ++j) v[j] = w[(size_t)j * NIN] * sc;
        u32x4 o; o.x = pk2(v[0], v[1]); o.y = pk2(v[2], v[3]); o.z = pk2(v[4], v[5]); o.w = pk2(v[6], v[7]);
        *(u32x4*)(p.WinT + ((size_t)l * NW + n) * DM + kc * 8) = o;
    }
    for (int l = 0; l < 2; ++l) {
        transpose_cvt(p.w_o + (size_t)l * DM * DM, p.WoT + (size_t)l * DM * DM, DM, DM, tid);
        transpose_cvt(p.w_up + (size_t)l * DM * NUP, p.WupT + (size_t)l * NUP * DM, DM, NUP, tid);
        transpose_cvt(p.w_down + (size_t)l * DFF * DM, p.WdT + (size_t)l * DM * DFF, DFF, DM, tid);
    }
    for (long i = gtid; i < 2L * 16 * 1024; i += gsz) {
        const int k = (int)(i & 1023), gi = (int)((i >> 10) & 15), l = (int)(i >> 14);
        p.WgT[i] = (bf16_t)f2bf(p.w_in[(size_t)l * DM * NIN + (size_t)k * NIN + 3072 + gi]);
    }
    for (long i = gtid; i < 4096L * 128; i += gsz) {
        const int pos = (int)(i >> 7), j = (int)(i & 127);
        const double inv = pow(10000.0, -(double)j / 128.0);
        const double ang = (double)pos * inv;
        const float c = (float)cos(ang), s = (float)sin(ang);
        p.cosT[i] = c; p.sinT[i] = s;
    }
}

DI void phase_ln(const float* src, const float* g, const float* b, float* dstf, bf16_t* dstb, int ntok, int tid,
                 unsigned char* smem, const float* wg  , const float* bias16, float* gpre) {
    const int wid = tid >> 6, lane = tid & 63;
    float* WgT = (float*)smem;
    if (wg) {
        for (int idx = tid; idx < 4096; idx += 512) {
            const int k = idx >> 2, j4 = idx & 3;
            const f32x4 w = *(const f32x4*)(wg + (size_t)k * NIN + 3072 + j4 * 4);
#pragma unroll
            for (int jj = 0; jj < 4; ++jj) WgT[(j4 * 4 + jj) * 1024 + k] = w[jj];
        }
        __syncthreads();
    }
    const int rstride = gridDim.x * 8;
    f32x4 gvv[4], bvv[4];
#pragma unroll
    for (int q = 0; q < 4; ++q) { gvv[q] = *(const f32x4*)(g + q * 256 + lane * 4); bvv[q] = *(const f32x4*)(b + q * 256 + lane * 4); }
    f32x4 nx[4];
    {
        const int r0 = blockIdx.x * 8 + wid;
        if (r0 < ntok) {
#pragma unroll
            for (int q = 0; q < 4; ++q) nx[q] = *(const f32x4*)(src + (size_t)r0 * DM + q * 256 + lane * 4);
        }
    }
    for (int row = blockIdx.x * 8 + wid; row < ntok; row += rstride) {
        f32x4 v[4]; float s = 0.f;
#pragma unroll
        for (int q = 0; q < 4; ++q) { v[q] = nx[q]; s += v[q][0] + v[q][1] + v[q][2] + v[q][3]; }
        if (row + rstride < ntok) {
#pragma unroll
            for (int q = 0; q < 4; ++q) nx[q] = *(const f32x4*)(src + (size_t)(row + rstride) * DM + q * 256 + lane * 4);
        }
#pragma unroll
        for (int o = 32; o >= 1; o >>= 1) s += __shfl_xor(s, o);
        const float mu = s * (1.f / 1024.f);
        float ss = 0.f;
#pragma unroll
        for (int q = 0; q < 4; ++q) { v[q] = v[q] - mu; ss += v[q][0] * v[q][0] + v[q][1] * v[q][1] + v[q][2] * v[q][2] + v[q][3] * v[q][3]; }
#pragma unroll
        for (int o = 32; o >= 1; o >>= 1) ss += __shfl_xor(ss, o);
        const float rstd = rsqrtf(ss * (1.f / 1024.f) + LN_EPS);
#pragma unroll
        for (int q = 0; q < 4; ++q) {
            const f32x4 y = v[q] * rstd * gvv[q] + bvv[q];
            v[q] = y;
            if (dstf) *(f32x4*)(dstf + (size_t)row * DM + q * 256 + lane * 4) = y;
            u32x2 w; w.x = pk2(y[0], y[1]); w.y = pk2(y[2], y[3]);
            if (dstb) *(u32x2*)(dstb + (size_t)row * DM + q * 256 + lane * 4) = w;
        }
        if (wg) {
            float acc[16];
#pragma unroll
            for (int gi = 0; gi < 16; ++gi) {
                float a = 0.f;
#pragma unroll
                for (int q = 0; q < 4; ++q) { const f32x4 w = *(const f32x4*)(WgT + gi * 1024 + q * 256 + lane * 4); a += v[q][0] * w[0] + v[q][1] * w[1] + v[q][2] * w[2] + v[q][3] * w[3]; }
                acc[gi] = a;
            }
#pragma unroll
            for (int st = 0; st < 4; ++st) {
                const int half = 8 >> st; const bool up = (lane >> st) & 1;
#pragma unroll
                for (int i = 0; i < 8; ++i) if (i < half) {
                    const float send = up ? acc[i] : acc[i + half];
                    const float keep = up ? acc[i + half] : acc[i];
                    acc[i] = keep + __shfl_xor(send, 1 << st);
                }
            }
            float r = acc[0];
            r += __shfl_xor(r, 16); r += __shfl_xor(r, 32);
            const int gidx = ((lane & 1) << 3) | (((lane >> 1) & 1) << 2) | (((lane >> 2) & 1) << 1) | ((lane >> 3) & 1);
            if (lane < 16) gpre[(size_t)row * 16 + gidx] = r + bias16[gidx];
        }
    }
}

DI void phase_gscan(const Params& p, const float* gpre, int nchunks, int tid) {
    const int wid = tid >> 6, lane = tid & 63;
    const int tstride = gridDim.x * 8, ntask = nchunks * 8;
    float ni0 = 0.f, nf0 = 0.f, ni1 = 0.f, nf1 = 0.f;
#define GS_LOAD(task_) do { const int ch_ = (task_) >> 3, dir_ = ((task_) >> 2) & 1, head_ = (task_) & 3; \
        const int q0_ = dir_ ? 127 - 2 * lane : 2 * lane, q1_ = dir_ ? 126 - 2 * lane : 2 * lane + 1; \
        const float* r0_ = gpre + (size_t)(ch_ * 128 + q0_) * 16 + dir_ * 8 + head_; const float* r1_ = gpre + (size_t)(ch_ * 128 + q1_) * 16 + dir_ * 8 + head_; \
        ni0 = r0_[0]; nf0 = r0_[4]; ni1 = r1_[0]; nf1 = r1_[4]; } while (0)
    { const int t0 = blockIdx.x * 8 + wid; if (t0 < ntask) GS_LOAD(t0); }
    for (int task = blockIdx.x * 8 + wid; task < ntask; task += tstride) {
        const int ch = task >> 3, dir = (task >> 2) & 1, head = task & 3;
        const int p0 = dir ? 127 - 2 * lane : 2 * lane, p1 = dir ? 126 - 2 * lane : 2 * lane + 1;
        const float i0 = ni0, f0 = nf0, i1 = ni1, f1 = nf1;
        if (task + tstride < ntask) GS_LOAD(task + tstride);
        const float l0 = fminf(f0, 0.f) - log1pf(__expf(-fabsf(f0))), l1 = fminf(f1, 0.f) - log1pf(__expf(-fabsf(f1)));
        const float pair = l0 + l1;
        float inc = pair;
#pragma unroll
        for (int d = 1; d < 64; d <<= 1) { const float t = __shfl_up(inc, d); if (lane >= d) inc += t; }
        const float exc = inc - pair;
        const float c0 = exc + l0, c1 = exc + pair;
        const float b0 = i0 - c0, b1 = i1 - c1;
        float mx = fmaxf(b0, b1);
#pragma unroll
        for (int d = 1; d < 64; d <<= 1) { const float t = __shfl_up(mx, d); if (lane >= d) mx = fmaxf(mx, t); }
        float mexc = __shfl_up(mx, 1); if (lane == 0) mexc = -3.0e38f;
        const float pm0 = fmaxf(mexc, b0), pm1 = fmaxf(pm0, b1);
        float* gp = p.gates + ((size_t)(ch * 2 + dir) * 4 + head) * 384;
        gp[p0] = b0; gp[128 + p0] = pm0; gp[256 + p0] = c0;
        gp[p1] = b1; gp[128 + p1] = pm1; gp[256 + p1] = c1;
    }
#undef GS_LOAD
}

DI void phase_gates2(const Params& p, unsigned char* smem, int layer, const bf16_t* xin, int nchunks, int tid) {
    const int wid = tid >> 6, lane = tid & 63, r16 = lane & 15, kq = lane >> 4;
    float* pre = (float*)smem;
    const bf16_t* wgt = p.WgT + (size_t)layer * 16 * DM;
    for (int ch = blockIdx.x; ch < nchunks; ch += gridDim.x) {
        {
            const bf16_t* ap = xin + (size_t)(ch * 128 + wid * 16 + r16) * DM + kq * 8;
            const bf16_t* bp = wgt + (size_t)r16 * DM + kq * 8;
            f32x4 acc = {0.f, 0.f, 0.f, 0.f};
#pragma unroll 8
            for (int ks = 0; ks < 32; ++ks) {
                const bf16x8 av = *(const bf16x8*)(ap + ks * 32), bv = *(const bf16x8*)(bp + ks * 32);
                acc = __builtin_amdgcn_mfma_f32_16x16x32_bf16(av, bv, acc, 0, 0, 0);
            }
            const float bb = p.b_if[layer * 16 + r16];
#pragma unroll
            for (int r = 0; r < 4; ++r) pre[(wid * 16 + kq * 4 + r) * 17 + r16] = acc[r] + bb;
        }
        __syncthreads();
        {
            const int dir = wid >> 2, head = wid & 3;
            const int p0 = dir ? 127 - 2 * lane : 2 * lane, p1 = dir ? 126 - 2 * lane : 2 * lane + 1;
            const float i0 = pre[p0 * 17 + dir * 8 + head], f0 = pre[p0 * 17 + dir * 8 + 4 + head];
            const float i1 = pre[p1 * 17 + dir * 8 + head], f1 = pre[p1 * 17 + dir * 8 + 4 + head];
            const float l0 = fminf(f0, 0.f) - log1pf(__expf(-fabsf(f0))), l1 = fminf(f1, 0.f) - log1pf(__expf(-fabsf(f1)));
            const float pair = l0 + l1;
            float inc = pair;
#pragma unroll
            for (int d = 1; d < 64; d <<= 1) { const float t = __shfl_up(inc, d); if (lane >= d) inc += t; }
            const float exc = inc - pair;
            const float c0 = exc + l0, c1 = exc + pair;
            const float b0 = i0 - c0, b1 = i1 - c1;
            float mx = fmaxf(b0, b1);
#pragma unroll
            for (int d = 1; d < 64; d <<= 1) { const float t = __shfl_up(mx, d); if (lane >= d) mx = fmaxf(mx, t); }
            float mexc = __shfl_up(mx, 1); if (lane == 0) mexc = -3.0e38f;
            const float pm0 = fmaxf(mexc, b0), pm1 = fmaxf(pm0, b1);
            float* gp = p.gates + ((size_t)(ch * 2 + dir) * 4 + head) * 384;
            gp[p0] = b0; gp[128 + p0] = pm0; gp[256 + p0] = c0;
            gp[p1] = b1; gp[128 + p1] = pm1; gp[256 + p1] = c1;
        }
        __syncthreads();
    }
}

DI void phase_merge(const Params& p, int layer, int ntok, int tid) {
    const int wid = tid >> 6, lane = tid & 63;
    const int ch0 = lane * 16;
    const int rstride = gridDim.x * 8;
    float gav[16], gbv[16];
#pragma unroll
    for (int j = 0; j < 16; j += 4) {
        const f32x4 t0 = *(const f32x4*)(p.g_a + layer * DM + ch0 + j), t1 = *(const f32x4*)(p.g_b + layer * DM + ch0 + j);
#pragma unroll
        for (int k = 0; k < 4; ++k) { gav[j + k] = t0[k]; gbv[j + k] = t1[k]; }
    }
    u32x4 pre[8][2];
#define MERGE_LOAD(r) do { \
        const u32x4* a0 = (const u32x4*)(p.H0 + (size_t)(r) * DM + ch0); const u32x4* a1 = (const u32x4*)(p.H1 + (size_t)(r) * DM + ch0); \
        const u32x4* b0 = (const u32x4*)(p.H2 + (size_t)(r) * DM + ch0); const u32x4* b1 = (const u32x4*)(p.H3 + (size_t)(r) * DM + ch0); \
        const u32x4* e = (const u32x4*)(p.E + (size_t)(r) * 4096 + ch0); \
        _Pragma("unroll") for (int q = 0; q < 2; ++q) { pre[0][q] = a0[q]; pre[1][q] = a1[q]; pre[2][q] = b0[q]; pre[3][q] = b1[q]; pre[4][q] = e[q]; pre[5][q] = e[128 + q]; pre[6][q] = e[256 + q]; pre[7][q] = e[384 + q]; } } while (0)
    { const int r0 = blockIdx.x * 8 + wid; if (r0 < ntok) MERGE_LOAD(r0); }
    for (int row = blockIdx.x * 8 + wid; row < ntok; row += rstride) {
        float ha[16], hb[16], oa[16], gb[16], ma[16], mb[16];
        {
            u32x4 cur[8][2];
#pragma unroll
            for (int i = 0; i < 8; ++i) { cur[i][0] = pre[i][0]; cur[i][1] = pre[i][1]; }
            if (row + rstride < ntok) MERGE_LOAD(row + rstride);
#pragma unroll
            for (int q = 0; q < 2; ++q) {
                const u32x4 x0 = cur[0][q], x1 = cur[1][q], y0 = cur[2][q], y1 = cur[3][q], eo = cur[4][q], eg = cur[5][q], em = cur[6][q], en = cur[7][q];
#pragma unroll
                for (int j = 0; j < 4; ++j) {
                    ha[q * 8 + 2 * j] = bflo(x0[j]) + bflo(x1[j]); ha[q * 8 + 2 * j + 1] = bfhi(x0[j]) + bfhi(x1[j]);
                    hb[q * 8 + 2 * j] = bflo(y0[j]) + bflo(y1[j]); hb[q * 8 + 2 * j + 1] = bfhi(y0[j]) + bfhi(y1[j]);
                    oa[q * 8 + 2 * j] = bflo(eo[j]); oa[q * 8 + 2 * j + 1] = bfhi(eo[j]);
                    gb[q * 8 + 2 * j] = bflo(eg[j]); gb[q * 8 + 2 * j + 1] = bfhi(eg[j]);
                    ma[q * 8 + 2 * j] = bflo(em[j]); ma[q * 8 + 2 * j + 1] = bfhi(em[j]);
                    mb[q * 8 + 2 * j] = bflo(en[j]); mb[q * 8 + 2 * j + 1] = bfhi(en[j]);
                }
            }
        }
        float sa = 0.f, sb = 0.f;
#pragma unroll
        for (int j = 0; j < 16; ++j) { ha[j] *= sigmoidf_(oa[j]); sa += ha[j]; sb += hb[j]; }
#pragma unroll
        for (int o = 8; o >= 1; o >>= 1) { sa += __shfl_xor(sa, o); sb += __shfl_xor(sb, o); }
        const float mua = sa * (1.f / 256.f), mub = sb * (1.f / 256.f);
        float va = 0.f, vb = 0.f;
#pragma unroll
        for (int j = 0; j < 16; ++j) { ha[j] -= mua; hb[j] -= mub; va += ha[j] * ha[j]; vb += hb[j] * hb[j]; }
#pragma unroll
        for (int o = 8; o >= 1; o >>= 1) { va += __shfl_xor(va, o); vb += __shfl_xor(vb, o); }
        const float ra = rsqrtf(va * (1.f / 256.f) + LN_EPS), rb = rsqrtf(vb * (1.f / 256.f) + LN_EPS);
        unsigned ow[8];
#pragma unroll
        for (int j = 0; j < 16; j += 2) {
            float r[2];
#pragma unroll
            for (int k = 0; k < 2; ++k) {
                const float ya = ha[j + k] * ra * gav[j + k];
                const float yb = hb[j + k] * rb * gbv[j + k] * (gb[j + k] * sigmoidf_(gb[j + k]));
                r[k] = sigmoidf_(ma[j + k]) * ya + sigmoidf_(mb[j + k]) * yb;
            }
            ow[j >> 1] = pk2(r[0], r[1]);
        }
        u32x4* op = (u32x4*)(p.merged + (size_t)row * DM + ch0);
        op[0] = (u32x4){ow[0], ow[1], ow[2], ow[3]}; op[1] = (u32x4){ow[4], ow[5], ow[6], ow[7]};
    }
}

DI float gelu_tanh(float x) {
    const float u = 0.7978845608028654f * (x + 0.044715f * x * x * x);
    const float e = __expf(2.f * u);
    const float th = 1.f - 2.f * frcp(e + 1.f);
    return 0.5f * x * (1.f + th);
}
DI void phase_conv(const Params& p, int layer, int ntok, int S, int tid) {
    const float* cw = p.conv_w + (size_t)layer * 3 * NUP; const float* cbias = p.conv_b + (size_t)layer * NUP;
    const int wid = tid >> 6, lane = tid & 63;
    constexpr int SEG = 16, NCW = 11;
    const int ntask = NCW * (ntok / SEG);
    for (int task = blockIdx.x * 8 + wid; task < ntask; task += gridDim.x * 8) {
        const int cwv = task % NCW, seg = task / NCW;
        const int c = (cwv * 64 + lane) * 4;
        const int t0 = seg * SEG, pos0 = t0 % S;
        const f32x4 wv0 = *(const f32x4*)(cw + c), wv1 = *(const f32x4*)(cw + NUP + c), wv2 = *(const f32x4*)(cw + 2 * NUP + c), bv = *(const f32x4*)(cbias + c);
        const f32x4 wg0 = *(const f32x4*)(cw + DFF + c), wg1 = *(const f32x4*)(cw + NUP + DFF + c), wg2 = *(const f32x4*)(cw + 2 * NUP + DFF + c), bg = *(const f32x4*)(cbias + DFF + c);
        const bf16_t* hv = p.hu + (size_t)t0 * NUP + c; const bf16_t* hg = hv + DFF;
        bf16_t* op = p.ff + (size_t)t0 * DFF + c;
        const u32x2 z = {0u, 0u};
        u32x2 rv[SEG + 2], rg[SEG + 2];
        rv[0] = pos0 > 0 ? *(const u32x2*)(hv - NUP) : z; rg[0] = pos0 > 0 ? *(const u32x2*)(hg - NUP) : z;
#pragma unroll
        for (int i = 0; i < SEG; ++i) { rv[i + 1] = *(const u32x2*)(hv + (size_t)i * NUP); rg[i + 1] = *(const u32x2*)(hg + (size_t)i * NUP); }
        { const bool hn = (pos0 + SEG - 1) < S - 1; rv[SEG + 1] = hn ? *(const u32x2*)(hv + (size_t)SEG * NUP) : z; rg[SEG + 1] = hn ? *(const u32x2*)(hg + (size_t)SEG * NUP) : z; }
#pragma unroll
        for (int i = 0; i < SEG; ++i) {
            const u32x2 pv = rv[i], cv = rv[i + 1], nv = rv[i + 2], pg = rg[i], cg = rg[i + 1], ng = rg[i + 2];
            const f32x4 pvf = {bflo(pv.x), bfhi(pv.x), bflo(pv.y), bfhi(pv.y)}, cvf = {bflo(cv.x), bfhi(cv.x), bflo(cv.y), bfhi(cv.y)}, nvf = {bflo(nv.x), bfhi(nv.x), bflo(nv.y), bfhi(nv.y)};
            const f32x4 pgf = {bflo(pg.x), bfhi(pg.x), bflo(pg.y), bfhi(pg.y)}, cgf = {bflo(cg.x), bfhi(cg.x), bflo(cg.y), bfhi(cg.y)}, ngf = {bflo(ng.x), bfhi(ng.x), bflo(ng.y), bfhi(ng.y)};
            const f32x4 val = wv0 * pvf + wv1 * cvf + wv2 * nvf + bv;
            const f32x4 gat = wg0 * pgf + wg1 * cgf + wg2 * ngf + bg;
            u32x2 o; o.x = pk2(gelu_tanh(gat[0]) * val[0], gelu_tanh(gat[1]) * val[1]); o.y = pk2(gelu_tanh(gat[2]) * val[2], gelu_tanh(gat[3]) * val[3]);
            *(u32x2*)(op + (size_t)i * DFF) = o;
        }
    }
}

#define BAR_LDS() do { asm volatile("s_waitcnt lgkmcnt(0)" ::: "memory"); __builtin_amdgcn_s_barrier(); asm volatile("" ::: "memory"); } while (0)
#define BAR_ALL() do { asm volatile("s_waitcnt vmcnt(0) lgkmcnt(0)" ::: "memory"); __builtin_amdgcn_s_barrier(); asm volatile("" ::: "memory"); } while (0)
template <int DK, bool ML>
DI void mixer_item(const int tid_in, unsigned char* smem, int S, int nch, int seq, int head, int dir, int split,
                   const bf16_t* Qg, const bf16_t* Kg, const bf16_t* KTg, const bf16_t* VTg, bf16_t* Hout, const float* gates, float lgv) {
    constexpr unsigned VTW_OFF = ML ? 98304u : 114688u;
    constexpr int KS = DK / 16, NST = DK / 128, NKP = DK * 16 / 512;
    int tid = tid_in; asm volatile("" : "+v"(tid));
    const int wid = __builtin_amdgcn_readfirstlane(tid >> 6), lane = tid & 63, l31 = lane & 31, hh = lane >> 5;
    const int vt = wid >> 2, tb = vt ? 7 - wid : wid;
#define MK_BASES(lo, to) \
    const unsigned l31x = ((lo) >> 4) & 31u, hhx = (lo) >> 9; \
    const unsigned a_ks = (unsigned)(vt * 2 * KS * 1024) + (lo); \
    const unsigned a_vt = (unsigned)(65536 + vt * 8 * 1024) + (lo); \
    const unsigned a_cs = (unsigned)(81920 + vt * KS * 1024) + (lo); \
    const unsigned a_ps = (unsigned)(114688 + tb * 8 * 1024) + (lo); \
    const unsigned a_psw = (unsigned)(114688 + (tb * 8 + vt * 4) * 1024) + l31x * 16 + 8 * hhx; \
    const unsigned a_csw = (unsigned)(81920 + (vt * KS + tb * 2) * 1024) + l31x * 16 + 8 * hhx; \
    const unsigned a_cp = (to); \
    const unsigned a_tv = (unsigned)(147456 + tb * 128) + l31x * 4; \
    const unsigned a_sv = (unsigned)(147456 + vt * 256) + 16 * hhx; \
    const unsigned a_hv = 147456u + hhx * 32; \
    const unsigned a_th = 147456u + ((to) >> 2);
    LAS unsigned char* const L = (LAS unsigned char*)smem;
#define LDSB(addr, off) (L + (addr) + (off))
#define LDG(T, base, off) (*(const T*)((const char*)(base) + (unsigned)(off)))
#define KDMA(Kptr, i) __builtin_amdgcn_global_load_lds((const unsigned*)((const char*)(Kptr) + (unsigned)(tofs + (i) * 8192)), (LAS unsigned*)(L + (unsigned)wid * 1024u + (i) * 8192), 16, 0, 0)
    {
        unsigned lo0 = lane * 16, to0 = tid * 16; asm volatile("" : "+v"(lo0), "+v"(to0));
        MK_BASES(lo0, to0)
        (void)a_ks; (void)a_vt; (void)a_cs; (void)a_ps; (void)a_psw; (void)a_csw; (void)a_tv; (void)a_sv; (void)a_hv;
        for (int i = 0; i < 64 * DK * 2 / 16 / 512; ++i) *(LAS u32x4*)LDSB(a_cp, 81920 + i * 8192) = (u32x4){0u, 0u, 0u, 0u};
        if (tid < 128) *(LAS float*)LDSB(a_th, 7 * 512) = 0.f;
        if (ML) {
#pragma unroll
            for (int i = 0; i < 3; ++i) {
                const unsigned ones = (i == 0 && (lo0 & (31u * 16u)) == 0u) ? 0x3F803F80u : 0u;
                *(LAS u32x4*)LDSB(a_cp, 32768 + i * 8192) = (u32x4){ones, ones, ones, ones};
            }
        }
    }
    f32x16 stC[NST];
    f32x16 stX;
#pragma unroll
    for (int r = 0; r < 16; ++r) stX[r] = 0.f;
#pragma unroll
    for (int i = 0; i < NST; ++i)
#pragma unroll
        for (int r = 0; r < 16; ++r) stC[i][r] = 0.f;
    float m = 0.f;
    const int last = dir ? 0 : 127;
    const int c0 = dir ? nch - 1 : 0;
    const size_t blk0 = ((size_t)seq * nch + c0) * 4 + head;
    bf16x8 qf[KS];
    u32x4 vtr[2];
    u32x4 kst[NKP];
    bf16x8 qfn[KS];
    float g_b = 0.f, g_pm = 0.f, g_cb = 0.f, g_pml = 0.f, g_cbl = 0.f;
    {
        unsigned lofs = lane * 16, tofs = tid * 16; asm volatile("" : "+v"(lofs), "+v"(tofs));
        const bf16_t* Kf = Kg + blk0 * (size_t)(128 * DK);
        if (ML) {
#pragma unroll
            for (int i = 0; i < NKP; ++i) kst[i] = LDG(u32x4, Kf, tofs + i * 8192);
        } else {
#pragma unroll
            for (int i = 0; i < NKP; ++i) KDMA(Kf, i);
        }
        const bf16_t* Qf = Qg + blk0 * (size_t)(128 * DK);
#pragma unroll
        for (int ks = 0; ks < KS; ++ks) qf[ks] = LDG(bf16x8, Qf + tb * KS * 512, lofs + ks * 1024);
        const bf16_t* VTf = VTg + blk0 * (size_t)(256 * 128) + split * (2 * 8 * 512);
#pragma unroll
        for (int i = 0; i < 2; ++i) vtr[i] = LDG(u32x4, VTf, tofs + i * 8192);
        if (ML) {
            const float* gp = gates + (((size_t)seq * nch + c0) * 2 + dir) * 4 * 384 + head * 384;
            g_pml = gp[128 + last]; g_cbl = gp[256 + last];
            if (tid < 128) { g_b = gp[tid]; g_pm = gp[128 + tid]; g_cb = gp[256 + tid]; }
        }
    }
    for (int ci = 0; ci < nch; ++ci) {
        const int c = dir ? nch - 1 - ci : ci;
        const bool has_next = ci + 1 < nch;
        unsigned lofs = lane * 16, tofs = tid * 16; asm volatile("" : "+v"(lofs), "+v"(tofs));
        float lgl = lgv; asm volatile("" : "+v"(lgl));
        const float rstep = ML ? 1.f : __expf(dir ? lgl : -lgl);
        MK_BASES(lofs, tofs)
        const int cn = dir ? c - 1 : c + 1;
        const size_t blk = ((size_t)seq * nch + c) * 4 + head;
        const size_t blkn = ((size_t)seq * nch + (has_next ? cn : c)) * 4 + head;
        const bf16_t* KTf = KTg + blk * (size_t)(DK * 128);
        const bf16_t* Kfn = Kg + blkn * (size_t)(128 * DK);
        if (ML) {
#pragma unroll
            for (int i = 0; i < NKP; ++i) *(LAS u32x4*)LDSB(a_cp, i * 8192) = kst[i];
        }
#pragma unroll
        for (int i = 0; i < 2; ++i) *(LAS u32x4*)LDSB(a_cp, 65536 + i * 8192) = vtr[i];
        float dec, m_new = 0.f;
        if (ML) {
            const float Ml = fmaxf(m, g_pml);
            dec = __expf(m - Ml); m_new = g_cbl + Ml;
            if (tid < 128) {
                const float M = fmaxf(m, g_pm);
                *(LAS float*)LDSB(a_th, 0) = g_b * 1.44269504089f; *(LAS float*)LDSB(a_th, 512) = M * 1.44269504089f; *(LAS float*)LDSB(a_th, 1024) = __expf(m - M);
                *(LAS float*)LDSB(a_th, 1536) = __expf(-g_cb - M); *(LAS float*)LDSB(a_th, 2048) = __expf(g_b - Ml); *(LAS float*)LDSB(a_th, 2560) = 0.f;
            }
        } else {
            dec = __expf(lgv * 128.f);
            if (ci == 0 && tid < 128) { *(LAS float*)LDSB(a_th, 1024) = __expf(lgv * (float)(dir ? (128 - tid) : (tid + 1))); *(LAS float*)LDSB(a_th, 2048) = __expf(lgv * (float)(dir ? tid : (127 - tid))); }
        }
        auto do_d0 = [&]() {
#pragma unroll
        for (int i = 0; i < 2; ++i) {
            const unsigned pidx = (unsigned)i * 512u + (tofs >> 4);
            const unsigned s0 = ((pidx >> 6) & 7u) * 16u + ((pidx >> 5) & 1u) * 8u;
            const u32x4 vv = *(const LAS u32x4*)LDSB(a_cp, 65536 + i * 8192);
            const f32x4 w0 = *(const LAS f32x4*)(L + 147456u + 4u * 512u + s0 * 4u), w1 = *(const LAS f32x4*)(L + 147456u + 4u * 512u + s0 * 4u + 16u);
            u32x4 o;
            o.x = pk2(bflo(vv.x) * w0[0], bfhi(vv.x) * w0[1]); o.y = pk2(bflo(vv.y) * w0[2], bfhi(vv.y) * w0[3]);
            o.z = pk2(bflo(vv.z) * w1[0], bfhi(vv.z) * w1[1]); o.w = pk2(bflo(vv.w) * w1[2], bfhi(vv.w) * w1[3]);
            *(LAS u32x4*)LDSB(a_cp, VTW_OFF + i * 8192) = o;
        }
        if (ML && tid < 16) {
            const unsigned s0 = (unsigned)(tid >> 1) * 16u + (unsigned)(tid & 1) * 8u;
            const f32x4 w0 = *(const LAS f32x4*)(L + 147456u + 4u * 512u + s0 * 4u), w1 = *(const LAS f32x4*)(L + 147456u + 4u * 512u + s0 * 4u + 16u);
            u32x4 o; o.x = pk2(w0[0], w0[1]); o.y = pk2(w0[2], w0[3]); o.z = pk2(w1[0], w1[1]); o.w = pk2(w1[2], w1[3]);
            *(LAS u32x4*)(L + 40960u + ((unsigned)(tid >> 1) * 64u + 32u * (unsigned)(tid & 1)) * 16u) = o;
        }
        };
        BAR_ALL();
        if (ML) do_d0();
        {
            float rsp = 0.f;
            const int t = tb * 32 + (int)l31x;
            const float Mtt = ML ? *(const LAS float*)LDSB(a_tv, 512) : 0.f;
#pragma unroll
            for (int sbi = 0; sbi < 2; ++sbi) {
                const int sb = vt * 2 + sbi;
                if (dir ? (sb < tb) : (sb > tb)) continue;
                f32x16 acc;
#pragma unroll
                for (int r = 0; r < 16; ++r) acc[r] = 0.f;
                {
                    bf16x8 fb[2][4];
#pragma unroll
                    for (int j = 0; j < 4; ++j) fb[0][j] = *(const LAS bf16x8*)LDSB(a_ks, (sbi * KS + j) * 1024);
#pragma unroll
                    for (int g = 0; g < KS / 4; ++g) {
                        if (g + 1 < KS / 4) {
#pragma unroll
                            for (int j = 0; j < 4; ++j) fb[(g + 1) & 1][j] = *(const LAS bf16x8*)LDSB(a_ks, (sbi * KS + (g + 1) * 4 + j) * 1024);
                        }
                        __builtin_amdgcn_sched_barrier(0);
#pragma unroll
                        for (int j = 0; j < 4; ++j) acc = MFMA32(fb[g & 1][j], qf[g * 4 + j], acc);
                        __builtin_amdgcn_sched_barrier(0);
                    }
                }
                const int mb = dir ? (t - sb * 32 - 4 * (int)hhx) : (sb * 32 + 4 * (int)hhx - t);
                float wk = 0.f, wr = 0.f;
                if (!ML) { wk = __expf(-lgl * (float)mb); wr = rstep; }
#pragma unroll
                for (int q = 0; q < 4; ++q) {
                    float v[4];
                    f32x4 bs4 = {0.f, 0.f, 0.f, 0.f};
                    if (ML) bs4 = *(const LAS f32x4*)LDSB(a_sv, (sbi * 32 + 8 * q) * 4);
#pragma unroll
                    for (int jj = 0; jj < 4; ++jj) {
                        const int k = 8 * q + jj;
                        const bool ok = mb <= (dir ? k : -k);
                        const float w = ML ? __builtin_amdgcn_exp2f(bs4[jj] - Mtt) : wk;
                        v[jj] = ok ? acc[q * 4 + jj] * w : 0.f;
                        rsp += v[jj];
                        if (!ML) wk *= wr;
                    }
                    if (!ML) { wk *= wr; wk *= wr; wk *= wr; wk *= wr; }
                    u32x2 o; o.x = pk2(v[0], v[1]); o.y = pk2(v[2], v[3]);
                    *(LAS u32x2*)LDSB(a_psw, (sbi * 2 + (q >> 1)) * 1024 + (q & 1) * 512) = o;
                }
            }
            (void)rsp;
        }
        BAR_LDS();
        if (has_next) {
            if (ML) {
#pragma unroll
                for (int i = 0; i < NKP; ++i) kst[i] = LDG(u32x4, Kfn, tofs + i * 8192);
                const bf16_t* Qfn = Qg + blkn * (size_t)(128 * DK);
#pragma unroll
                for (int ks = 0; ks < KS; ++ks) qfn[ks] = LDG(bf16x8, Qfn + tb * KS * 512, lofs + ks * 1024);
                const bf16_t* VTfn = VTg + blkn * (size_t)(256 * 128) + split * (2 * 8 * 512);
#pragma unroll
                for (int i = 0; i < 2; ++i) vtr[i] = LDG(u32x4, VTfn, tofs + i * 8192);
                const float* gp = gates + (((size_t)seq * nch + cn) * 2 + dir) * 4 * 384 + head * 384;
                g_pml = gp[128 + last]; g_cbl = gp[256 + last];
                if (tid < 128) { g_b = gp[tid]; g_pm = gp[128 + tid]; g_cb = gp[256 + tid]; }
            } else {
#pragma unroll
                for (int i = 0; i < NKP; ++i) KDMA(Kfn, i);
            }
        }
        bf16x8 kt[8];
        {
            f32x16 a1, a2;
#pragma unroll
            for (int r = 0; r < 16; ++r) { a1[r] = 0.f; a2[r] = 0.f; }
            f32x16 a1x, a2x;
#pragma unroll
            for (int r = 0; r < 16; ++r) { a1x[r] = 0.f; a2x[r] = 0.f; }
            {
#pragma unroll
                for (int g = 0; g < 4; ++g) {
                    if (dir ? (g < tb) : (g > tb)) continue;
                    const bf16x8 fa0 = *(const LAS bf16x8*)LDSB(a_vt, (g * 2) * 1024), fa1 = *(const LAS bf16x8*)LDSB(a_vt, (g * 2 + 1) * 1024);
                    const bf16x8 fp0 = *(const LAS bf16x8*)LDSB(a_ps, (g * 2) * 1024), fp1 = *(const LAS bf16x8*)LDSB(a_ps, (g * 2 + 1) * 1024);
                    a1 = MFMA32(fa0, fp0, a1); a1 = MFMA32(fa1, fp1, a1);
                    if (ML) {
                        const bf16x8 fx0 = *(const LAS bf16x8*)(L + lofs + 32768u + (g * 2) * 1024), fx1 = *(const LAS bf16x8*)(L + lofs + 32768u + (g * 2 + 1) * 1024);
                        a1x = MFMA32(fx0, fp0, a1x); a1x = MFMA32(fx1, fp1, a1x);
                    }
                }
                bf16x8 fc[2][4];
#pragma unroll
                for (int j = 0; j < 4; ++j) fc[0][j] = *(const LAS bf16x8*)LDSB(a_cs, j * 1024);
#pragma unroll
                for (int g = 0; g < KS / 4; ++g) {
                    if (g + 1 < KS / 4) {
#pragma unroll
                        for (int j = 0; j < 4; ++j) fc[(g + 1) & 1][j] = *(const LAS bf16x8*)LDSB(a_cs, ((g + 1) * 4 + j) * 1024);
                    }
                    __builtin_amdgcn_sched_barrier(0);
#pragma unroll
                    for (int j = 0; j < 4; ++j) a2 = MFMA32(fc[g & 1][j], qf[g * 4 + j], a2);
                    __builtin_amdgcn_sched_barrier(0);
                }
            }
            if (ML) {
#pragma unroll
                for (int ks = 0; ks < KS; ++ks) { const bf16x8 fcx = *(const LAS bf16x8*)(L + lofs + 49152u + ks * 1024); a2x = MFMA32(fcx, qf[ks], a2x); }
            }
#pragma unroll
            for (int ks = 0; ks < 8; ++ks) kt[ks] = LDG(bf16x8, KTf + tb * 8 * 512, lofs + ks * 1024);
            const int t = tb * 32 + (int)l31x; const float wi = *(const LAS float*)LDSB(a_tv, 2 * 512); float inv = 1.f;
            if (ML) { const float d0v = a1x[0] + wi * a2x[0]; const float dsw = __shfl_xor(d0v, 32); const float den = hhx ? dsw : d0v; inv = frcp(fmaxf(fabsf(den), *(const LAS float*)LDSB(a_tv, 3 * 512))); }
            bf16_t* hp = Hout + ((size_t)seq * S + (size_t)c * 128 + t) * DM + head * 256 + split * 64 + vt * 32 + 4 * (int)hhx;
#pragma unroll
            for (int q = 0; q < 4; ++q) {
                u32x2 o; o.x = pk2((a1[q * 4] + wi * a2[q * 4]) * inv, (a1[q * 4 + 1] + wi * a2[q * 4 + 1]) * inv);
                o.y = pk2((a1[q * 4 + 2] + wi * a2[q * 4 + 2]) * inv, (a1[q * 4 + 3] + wi * a2[q * 4 + 3]) * inv);
                *(u32x2*)(hp + 8 * q) = o;
            }
        }
        BAR_LDS();
        if (!ML && has_next) {
            const bf16_t* VTfn = VTg + blkn * (size_t)(256 * 128) + split * (2 * 8 * 512);
#pragma unroll
            for (int i = 0; i < 2; ++i) vtr[i] = LDG(u32x4, VTfn, tofs + i * 8192);
        }
        if (!ML) { do_d0(); BAR_LDS(); }
        bf16x8 fv[8];
#pragma unroll
        for (int ks = 0; ks < 8; ++ks) fv[ks] = *(const LAS bf16x8*)LDSB(a_vt, (VTW_OFF - 65536u) + ks * 1024);
#pragma unroll
        for (int i = 0; i < NST; ++i) {
            bf16x8 ktn[8];
            if (i + 1 < NST) {
#pragma unroll
                for (int ks = 0; ks < 8; ++ks) ktn[ks] = LDG(bf16x8, KTf + (tb + 4 * (i + 1)) * 8 * 512, lofs + ks * 1024);
            }
            if (ML && vt == 0) {
#pragma unroll
                for (int r = 0; r < 16; ++r) stX[r] *= dec;
#pragma unroll
                for (int ks = 0; ks < 8; ++ks) { const bf16x8 fw = *(const LAS bf16x8*)(L + lofs + 40960u + ks * 1024); stX = MFMA32(kt[ks], fw, stX); }
#pragma unroll
                for (int q = 0; q < 4; ++q) {
                    u32x2 o; o.x = pk2(stX[q * 4], stX[q * 4 + 1]); o.y = pk2(stX[q * 4 + 2], stX[q * 4 + 3]);
                    *(LAS u32x2*)(L + 49152u + (unsigned)((tb * 2 + (q >> 1)) * 1024 + (q & 1) * 512) + l31x * 16u + 8u * hhx) = o;
                }
            }
#pragma unroll
            for (int r = 0; r < 16; ++r) stC[i][r] *= dec;
            __builtin_amdgcn_sched_barrier(0);
#pragma unroll
            for (int ks = 0; ks < 8; ++ks) stC[i] = MFMA32(kt[ks], fv[ks], stC[i]);
            __builtin_amdgcn_sched_barrier(0);
#pragma unroll
            for (int q = 0; q < 4; ++q) {
                u32x2 o; o.x = pk2(stC[i][q * 4], stC[i][q * 4 + 1]); o.y = pk2(stC[i][q * 4 + 2], stC[i][q * 4 + 3]);
                *(LAS u32x2*)LDSB(a_csw, (8 * i + (q >> 1)) * 1024 + (q & 1) * 512) = o;
            }
            if (i + 1 < NST) {
#pragma unroll
                for (int ks = 0; ks < 8; ++ks) kt[ks] = ktn[ks];
            }
            if (NST > 1 && i == 0 && has_next) {
                const bf16_t* Qfn = Qg + blkn * (size_t)(128 * DK);
#pragma unroll
                for (int ks = 0; ks < KS; ++ks) qf[ks] = LDG(bf16x8, Qfn + tb * KS * 512, lofs + ks * 1024);
            }
        }
        if (ML && has_next) {
#pragma unroll
            for (int ks = 0; ks < KS; ++ks) qf[ks] = qfn[ks];
        }
        if (ML) m = m_new;
        BAR_LDS();
    }
#undef LDSB
#undef KDMA
#undef LDG
#undef MK_BASES
}

DI void phase_mixer(const Params& p, unsigned char* smem, int layer, int S, int nseq, int tid) {
    const int nch = S / 128, NI = nseq * 32;
    for (int it = blockIdx.x; it < 2 * NI; it += gridDim.x) {
        const int mixer = it / NI, r = it % NI;
        const int head = r & 3, dir = (r >> 2) & 1, split = (r >> 3) & 3, seq = r >> 5;
        if (mixer == 0) mixer_item<256, false>(tid, smem, S, nch, seq, head, dir, split, p.Qb, p.Kb, p.KbT, p.VbT, dir ? p.H3 : p.H2, nullptr, p.lg[layer * 8 + dir * 4 + head]);
        else mixer_item<128, true>(tid, smem, S, nch, seq, head, dir, split, p.Qa, p.Ka, p.KaT, p.VaT, dir ? p.H1 : p.H0, p.gates, 0.f);
    }
}


#define XB_TMO      128
#define XB_XCNT(j)  (256  + 64 * (j))
#define XB_XSUB(j)  (1280 + 64 * (j))
#define XB_XGEN(j)  (2304 + 64 * (j))
#define XB_TOP      3328
#define XB_TOPGEN   3392
#define XCD_BAR_WORDS 3456
#define XB_SPIN_CAP (1u << 22)
DI unsigned xb_ld(unsigned* p)              { return __hip_atomic_load(p, __ATOMIC_RELAXED, __HIP_MEMORY_SCOPE_AGENT); }
DI unsigned xb_add(unsigned* p, unsigned v) { return __hip_atomic_fetch_add(p, v, __ATOMIC_RELAXED, __HIP_MEMORY_SCOPE_AGENT); }
DI unsigned xb_xcc_id() { return (unsigned)__builtin_amdgcn_s_getreg((3 << 11) | 20) & 0xFu; }
#define XB_SPIN(cond, bar) do { unsigned _sp = 0; while (cond) { __builtin_amdgcn_s_sleep(1); \
    if ((++_sp & 255u) == 0u) { if (xb_ld(&(bar)[XB_TMO])) break; if (_sp > XB_SPIN_CAP) { atomicAdd(&(bar)[XB_TMO], 1u); break; } } } } while (0)
struct XcdBarrier { unsigned* bar; unsigned x; volatile LAS unsigned* st; };
DI XcdBarrier xcd_barrier_post(unsigned* bar, volatile LAS unsigned* st, int tid) {
    XcdBarrier b; b.bar = bar; b.x = xb_xcc_id(); b.st = st;
    if (tid == 0) (void)xb_add(&bar[XB_XCNT(b.x)], 1u);
    return b;
}
DI void xcd_barrier_complete(unsigned* bar, unsigned x, unsigned& nloc, unsigned& nx) {
    const unsigned G = gridDim.x * gridDim.y * gridDim.z;
    unsigned sum, cnt, mine, sp = 0u;
    for (;;) {
        sum = 0u; cnt = 0u; mine = 0u;
#pragma unroll
        for (unsigned j = 0; j < 16; ++j) { const unsigned c = xb_ld(&bar[XB_XCNT(j)]); sum += c; cnt += (c > 0u) ? 1u : 0u; mine = (j == x) ? c : mine; }
        if (sum == G) break;
        __builtin_amdgcn_s_sleep(1);
        if ((++sp & 255u) == 0u) { if (xb_ld(&bar[XB_TMO])) break; if (sp > XB_SPIN_CAP) { atomicAdd(&bar[XB_TMO], 1u); break; } }
    }
    nloc = mine > 0u ? mine : 1u; nx = cnt > 0u ? cnt : 1u;
}
DI void xcd_barrier(const XcdBarrier& b, int tid) {
    asm volatile("s_waitcnt vmcnt(0)" ::: "memory");
    __syncthreads();
    if (tid == 0) {
        unsigned* bar = b.bar;
        __builtin_amdgcn_s_waitcnt(0);
        unsigned nloc = b.st[0], nx = b.st[1];
        if (nloc == 0u) { xcd_barrier_complete(bar, b.x, nloc, nx); b.st[0] = nloc; b.st[1] = nx; }
        const unsigned old = xb_add(&bar[XB_XSUB(b.x)], 1u);
        const unsigned gen = old / nloc;
        if (old + 1u == (gen + 1u) * nloc) {
            __builtin_amdgcn_fence(__ATOMIC_RELEASE, "agent");
            asm volatile("s_waitcnt vmcnt(0)" ::: "memory");
            const unsigned og = xb_add(&bar[XB_TOP], 1u);
            const unsigned tg = og / nx;
            if (og + 1u == (tg + 1u) * nx) xb_add(&bar[XB_TOPGEN], 1u);
            else XB_SPIN(xb_ld(&bar[XB_TOPGEN]) == tg, bar);
            __builtin_amdgcn_fence(__ATOMIC_ACQUIRE, "agent");
            xb_add(&bar[XB_XGEN(b.x)], 1u);
            asm volatile("s_waitcnt vmcnt(0)" ::: "memory");
        } else {
            XB_SPIN(xb_ld(&bar[XB_XGEN(b.x)]) == gen, bar);
            __builtin_amdgcn_fence(__ATOMIC_ACQUIRE, "agent");
            asm volatile("s_waitcnt vmcnt(0)" ::: "memory");
        }
    }
    __syncthreads();
}

DI size_t al256(size_t x) { return (x + 255) & ~(size_t)255; }
DI void build_params(Params& p, const KArgs& a, char* w, int G) {
    p.x_prompt = a.in[0]; p.x_sample = a.in[1]; p.ln_in_g = a.in[2]; p.ln_in_b = a.in[3]; p.w_in = a.in[4]; p.b_if = a.in[5]; p.lg = a.in[6]; p.g_a = a.in[7]; p.g_b = a.in[8];
    p.w_o = a.in[9]; p.ln1_g = a.in[10]; p.ln1_b = a.in[11]; p.w_up = a.in[12]; p.conv_w = a.in[13]; p.conv_b = a.in[14]; p.w_down = a.in[15]; p.ln2_g = a.in[16]; p.ln2_b = a.in[17];
    p.out = a.out; p.G = G; p.pad = 0;
    size_t o = 0;
    p.WinT = (bf16_t*)(w + o); o += al256((size_t)2 * NW * DM * 2);
    p.WoT = (bf16_t*)(w + o); o += al256((size_t)2 * DM * DM * 2);
    p.WupT = (bf16_t*)(w + o); o += al256((size_t)2 * NUP * DM * 2);
    p.WdT = (bf16_t*)(w + o); o += al256((size_t)2 * DM * DFF * 2);
    p.cosT = (float*)(w + o); o += (size_t)4096 * 128 * 4; p.sinT = (float*)(w + o); o += (size_t)4096 * 128 * 4;
    p.cosTT = (float*)(w + o); o += (size_t)4096 * 128 * 4; p.sinTT = (float*)(w + o); o += (size_t)4096 * 128 * 4;
    p.gates = (float*)(w + o); o += (size_t)G * 96;
    p.gpre = (float*)(w + o); o += (size_t)G * 64;
    p.WgT = (bf16_t*)(w + o); o += 65536;
    char* ubase = w + o;
    const size_t g1 = (size_t)G * 1024;
    p.Qb = (bf16_t*)(w + o); o += 2 * g1; p.Kb = (bf16_t*)(w + o); o += 2 * g1;
    p.Qa = (bf16_t*)(w + o); o += g1; p.Ka = (bf16_t*)(w + o); o += g1;
    p.E = (bf16_t*)(w + o); o += 8 * g1;
    p.KbT = (bf16_t*)(w + o); o += 2 * g1; p.KaT = (bf16_t*)(w + o); o += g1;
    p.VaT = (bf16_t*)(w + o); o += 2 * g1; p.VbT = (bf16_t*)(w + o); o += 2 * g1;
    p.H0 = (bf16_t*)(w + o); o += 2 * g1; p.H1 = (bf16_t*)(w + o); o += 2 * g1;
    p.H2 = (bf16_t*)(w + o); o += 2 * g1; p.H3 = (bf16_t*)(w + o); o += 2 * g1;
    p.xb = p.H0; p.merged = (bf16_t*)ubase; p.hu = (bf16_t*)ubase; p.ff = (bf16_t*)(ubase + (size_t)G * NUP * 2);
}
DI void run_phase(const Params& p, unsigned char* smem, int ph, const int tid) {
    const int G = p.G;
    const int g = (ph - 1) / 19, q = (ph - 1) % 19;
    const int T0 = g * G;
    const int S = T0 < TPROMPT ? 2048 : 4096;
    const int nseq = G / S;
    float* xg = p.out + (size_t)T0 * DM;
    bf16_t* xin = (bf16_t*)xg;
    float* yb = (float*)p.H2;
    LAS unsigned char* lds = (LAS unsigned char*)smem;
    if (q == 0) return;
    const int l = (q - 1) / 9, k = (q - 1) % 9;
    pg8::StaticOrder so;
    switch (k) {
    case 0: {
        { pg8::Gemm gm{xin, p.WinT + (size_t)l * NW * DM, G, NNORM, DM}; so.init(gm.M, gm.N, (int)gridDim.x, (int)blockIdx.x); EpiInN e{&p, S, smem}; pg8::gemm_phase(lds, gm, so, e, tid); }
        { pg8::Gemm gm{p.WinT + ((size_t)l * NW + NNORM) * DM, xin, NTR, G, DM}; so.init(gm.M, gm.N, (int)gridDim.x, (int)blockIdx.x); EpiInT e{&p, S}; pg8::gemm_phase(lds, gm, so, e, tid); }
        phase_gates2(p, smem, l, xin, G / 128, tid);
    } break;
    case 1: phase_mixer(p, smem, l, S, nseq, tid); break;
    case 2: phase_merge(p, l, G, tid); break;
    case 3: { pg8::Gemm gm{p.merged, p.WoT + (size_t)l * DM * DM, G, DM, DM}; so.init(gm.M, gm.N, (int)gridDim.x, (int)blockIdx.x); EpiRes<true> e{yb, xin}; pg8::gemm_phase(lds, gm, so, e, tid); } break;
    case 4: phase_ln(yb, p.ln1_g + l * DM, p.ln1_b + l * DM, nullptr, p.xb, G, tid, smem, nullptr, nullptr, nullptr); break;
    case 5: { pg8::Gemm gm{p.xb, p.WupT + (size_t)l * NUP * DM, G, NUP, DM}; so.init(gm.M, gm.N, (int)gridDim.x, (int)blockIdx.x); EpiB16 e{p.hu, NUP}; pg8::gemm_phase(lds, gm, so, e, tid); } break;
    case 6: phase_conv(p, l, G, S, tid); break;
    case 7: { pg8::Gemm gm{p.ff, p.WdT + (size_t)l * DM * DFF, G, DM, DFF}; so.init(gm.M, gm.N, (int)gridDim.x, (int)blockIdx.x); EpiRes<true> e{yb, p.xb}; pg8::gemm_phase(lds, gm, so, e, tid); } break;
    default: {
        const int T1 = T0 + G;
        const int nrep = (l == 1 && T1 < TTOT) ? 2 : 1;
        _Pragma("nounroll") for (int rep = 0; rep < nrep; ++rep) {
            const float* src; const float* gg; const float* bb; float* df; bf16_t* db;
            if (rep == 0) { src = yb; gg = p.ln2_g + l * DM; bb = p.ln2_b + l * DM; df = l == 1 ? xg : nullptr; db = l == 1 ? nullptr : xin; }
            else { src = T1 < TPROMPT ? p.x_prompt + (size_t)T1 * DM : p.x_sample + (size_t)(T1 - TPROMPT) * DM; gg = p.ln_in_g; bb = p.ln_in_b; df = nullptr; db = (bf16_t*)(p.out + (size_t)T1 * DM); }
            phase_ln(src, gg, bb, df, db, G, tid, smem, nullptr, nullptr, nullptr);
        }
    } break;
    }
}

__global__ __launch_bounds__(512, 2) void mega(KArgs a, int ph_lo, int ph_hi) {
    extern __shared__ __attribute__((aligned(16))) unsigned char smem[];
    const int wid0 = __builtin_amdgcn_readfirstlane((int)threadIdx.x >> 6);
#define MK_TID() (wid0 * 64 + (int)__builtin_amdgcn_mbcnt_hi(~0u, __builtin_amdgcn_mbcnt_lo(~0u, 0u)))
    const bool multi = ph_hi - ph_lo > 1;
    XcdBarrier xb; xb.bar = a.bar; xb.x = 0; xb.st = (volatile LAS unsigned*)((LAS unsigned char*)smem + 151552);
    if (multi) {
        int tid1 = MK_TID(); asm volatile("" : "+v"(tid1));
        if (tid1 == 0) { xb.st[0] = 0u; xb.st[1] = 0u; }
        __syncthreads();
        xb = xcd_barrier_post(a.bar, xb.st, tid1);
    }
    if (ph_hi < -1000) cg::this_grid().sync();
    if (ph_lo == 0) {
        int tid0 = MK_TID(); asm volatile("" : "+v"(tid0));
        Params p; build_params(p, a, a.ws, a.G);
        phase_prep(p, tid0);
        phase_ln(p.x_prompt, p.ln_in_g, p.ln_in_b, nullptr, (bf16_t*)p.out, a.G, tid0, smem, nullptr, nullptr, nullptr);
        ph_lo = 1;
        if (ph_lo < ph_hi) xcd_barrier(xb, tid0);
    }
    for (int ph = ph_lo; ph < ph_hi; ++ph) {
        int wq = wid0; asm volatile("" : "+s"(wq));
        int tid = wq * 64 + (int)__builtin_amdgcn_mbcnt_hi(~0u, __builtin_amdgcn_mbcnt_lo(~0u, 0u)); asm volatile("" : "+v"(tid));
        int G = a.G; char* w = a.ws; asm volatile("" : "+s"(G));
        Params p; build_params(p, a, w, G);
        if ((ph - 1) % 19 == 0) continue;
        run_phase(p, smem, ph, tid);
        if (ph + 1 < ph_hi) xcd_barrier(xb, tid);
    }
}

#ifndef ONE_LAUNCH
#define ONE_LAUNCH 1
#endif

extern "C" void kernel_launch(void* const* d_in, const int* in_sizes, int n_in, void* d_out, int out_size, void* d_ws, size_t ws_size, hipStream_t stream) {
    static int grid = 0;
    if (grid == 0) {
        int dev = 0, cus = 0, per_cu = 0;
        hipGetDevice(&dev);
        hipDeviceGetAttribute(&cus, hipDeviceAttributeMultiprocessorCount, dev);
        hipFuncSetAttribute((const void*)mega, hipFuncAttributeMaxDynamicSharedMemorySize, LDS_BYTES);
        hipOccupancyMaxActiveBlocksPerMultiprocessor(&per_cu, (const void*)mega, 512, LDS_BYTES);
        (void)hipGetLastError();
        if (per_cu < 1) per_cu = 1;
        if (cus <= 0) cus = 256;
        grid = cus;
    }
    KArgs p{};
    for (int i = 0; i < 18; ++i) p.in[i] = (const float*)d_in[i];
    p.out = (float*)d_out; p.ws = (char*)d_ws + 16384; p.bar = (unsigned*)d_ws;
    auto need = [](size_t G) { return (size_t)2 * NW * DM * 2 + (size_t)2 * DM * DM * 2 + (size_t)2 * NUP * DM * 2 + (size_t)2 * DM * DFF * 2 + (size_t)4 * 4096 * 128 * 4 + G * 160 + G * (size_t)(NW) * 2 + G * (size_t)4 * DM * 2 + 4096 + 16384 + 65536; };
    int G = 32768;
    if (need(G) > ws_size) G = 16384;
    p.G = G;
    const int ngroups = TTOT / G;
    const int nph = 1 + ngroups * 19;
#if ONE_LAUNCH
    hipMemsetAsync(d_ws, 0, 16384, stream);
    int lo = 0, hi = nph;
    void* args[] = {&p, &lo, &hi};
    hipError_t e = hipLaunchCooperativeKernel((const void*)mega, dim3(grid), dim3(512), args, LDS_BYTES, stream);
    if (e != hipSuccess) fprintf(stderr, "cooperative launch failed: %s (grid %d)\n", hipGetErrorString(e), grid);
#else
    for (int ph = 0; ph < nph; ++ph) hipLaunchKernelGGL(mega, dim3(grid), dim3(512), LDS_BYTES, stream, p, ph, ph + 1);
#endif
}
```

```cpp
#include <hip/hip_runtime.h>
#include <hip/hip_cooperative_groups.h>
#include <cstdio>
namespace cg = cooperative_groups;

#define LAS __attribute__((address_space(3)))
#define DI __device__ __forceinline__
typedef unsigned short bf16_t;
typedef short bf16x8 __attribute__((ext_vector_type(8)));
typedef float f32x4 __attribute__((ext_vector_type(4)));
typedef float f32x16 __attribute__((ext_vector_type(16)));
typedef unsigned u32x4 __attribute__((ext_vector_type(4)));
typedef unsigned u32x2 __attribute__((ext_vector_type(2)));

constexpr int DM = 1024, NIN = 9232, DFF = 2816, NUP = 5632;
constexpr int NNORM = 7168, NTR = 2048, NW = NNORM + NTR;
constexpr int TTOT = 98304, TPROMPT = 65536;
constexpr int LDS_BYTES = 151552 + 16;
constexpr float ALPHA = 1.41421356237f;
constexpr float LN_EPS = 1e-5f;

struct KArgs {
    const float* in[18];
    float* out; char* ws; unsigned* bar;
    int G; int pad;
};
struct Params {
    const float* x_prompt; const float* x_sample; const float* ln_in_g; const float* ln_in_b; const float* w_in; const float* b_if;
    const float* lg; const float* g_a; const float* g_b; const float* w_o; const float* ln1_g; const float* ln1_b; const float* w_up;
    const float* conv_w; const float* conv_b; const float* w_down; const float* ln2_g; const float* ln2_b;
    float* out;
    bf16_t* WinT; bf16_t* WoT; bf16_t* WupT; bf16_t* WdT;
    float* cosT; float* sinT; float* cosTT; float* sinTT;
    float* gates; float* gpre; bf16_t* WgT;
    bf16_t* Qb; bf16_t* Kb; bf16_t* Qa; bf16_t* Ka; bf16_t* E; bf16_t* KbT; bf16_t* KaT; bf16_t* VaT; bf16_t* VbT;
    bf16_t* H0; bf16_t* H1; bf16_t* H2; bf16_t* H3;
    bf16_t* xb; bf16_t* merged; bf16_t* hu; bf16_t* ff;
    int G; int pad;
};

typedef float f32x2 __attribute__((ext_vector_type(2)));
typedef __bf16 bf16v2 __attribute__((ext_vector_type(2)));
DI unsigned f2bf(float x) { unsigned u = __float_as_uint(x); u += 0x7fffu + ((u >> 16) & 1u); return u >> 16; }
DI unsigned pk2(float lo, float hi) { const f32x2 v = {lo, hi}; return __builtin_bit_cast(unsigned, __builtin_convertvector(v, bf16v2)); }
DI float bflo(unsigned w) { return __uint_as_float(w << 16); }
DI float bfhi(unsigned w) { return __uint_as_float(w & 0xffff0000u); }
DI float frcp(float x) { return __builtin_amdgcn_rcpf(x); }
DI float sigmoidf_(float x) { return frcp(1.f + __expf(-x)); }
#define MFMA32(a, b, c) __builtin_amdgcn_mfma_f32_32x32x16_bf16((a), (b), (c), 0, 0, 0)

namespace pg8 {
constexpr int BM = 256, BK = 64, HALF = 128, HTB = HALF * BK * 2, STAGE_BYTES = 8 * HTB, NXCD = 8, WGM = 8;
DI int lds_byte(int r, int c) { const int st = (r >> 4) * 2 + (c >> 5), rr = r & 15, cc = c & 31, ob = rr * 64 + cc * 2; return st * 1024 + (ob ^ (((ob >> 9) & 1) << 5)); }
DI void stage_rc(int b, int& R, int& C) { const int st = b / 1024, sb = b % 1024, swz = sb ^ (((sb >> 9) & 1) << 5); R = (st >> 1) * 16 + swz / 64; C = (st & 1) * 32 + (swz % 64) / 2; }
DI int perm32(int rho) { const int n = rho >> 4, i = rho & 15; return 8 * (i >> 2) + 4 * n + (i & 3); }
struct Unit { int pm, pn; };
struct Gemm { const bf16_t* A; const bf16_t* Bt; int M, N, K; };
struct StaticOrder {
    int nM, nN, nwg, G, c;
    DI void init(int M, int N, int G_, int c_) { nM = M / BM; nN = N / BM; nwg = nM * nN; G = G_; c = c_; }
    DI bool next(int i, Unit& u) const {
        const long L = (long)i * G + c; if (L >= nwg) return false;
        int wgid = (int)L; { const int q = nwg / NXCD, r = nwg % NXCD, xcd = wgid % NXCD, off = wgid / NXCD; wgid = (xcd < r ? xcd * (q + 1) : r * (q + 1) + (xcd - r) * q) + off; }
        const int nig = WGM * nN, gid = wgid / nig, fm = gid * WGM, gsz = (nM - fm) < WGM ? (nM - fm) : WGM;
        u.pm = fm + ((wgid % nig) % gsz); u.pn = (wgid % nig) / gsz; return true;
    }
};

template <class Epi>
DI void gemm_phase(LAS unsigned char* lds, const Gemm g, const StaticOrder& S, const Epi& E, const int tid) {
    const int wid = __builtin_amdgcn_readfirstlane(tid >> 6), lane = tid & 63, wr = wid >> 2, wc = wid & 3, fr = lane & 15, fq = lane >> 4;
    const int K = g.K, nt = K / BK;
    unsigned voffA[2], voffB[2];
#pragma unroll
    for (int i = 0; i < 2; ++i) { int R, C; stage_rc(tid * 16 + i * 8192, R, C); const int Rb = Epi::PERM ? ((R & ~31) + perm32(R & 31)) : R;
        voffA[i] = (unsigned)(R * K + C) * 2u; voffB[i] = (unsigned)(Rb * K + C) * 2u; }
    const size_t kstep = (size_t)(BK * 2);
    const size_t hstep = (size_t)HALF * K * 2;
    const size_t tstep = 2 * hstep;
    const unsigned ldsw = (unsigned)wid * 1024u;
    const int aoff = lds_byte(wr * 64 + fr, fq * 8), boff = lds_byte(wc * 32 + fr, fq * 8);
#define PG8_SA(b, h) (((b) * 2 + (h)) * HTB)
#define PG8_SB(b, h) ((4 + (b) * 2 + (h)) * HTB)
#define PG8_STAGE(bufoff, gbase, voff) do { _Pragma("unroll") for (int _i = 0; _i < 2; ++_i) \
        __builtin_amdgcn_global_load_lds((const unsigned*)((const char*)(gbase) + (voff)[_i]), (LAS unsigned*)(lds + (bufoff) + ldsw + _i * 8192), 16, 0, 0); } while (0)
#define PG8_LDA(dst, b, h) do { _Pragma("unroll") for (int m = 0; m < 4; ++m) _Pragma("unroll") for (int k = 0; k < 2; ++k) dst[m][k] = *(const LAS bf16x8*)(lds + PG8_SA(b, h) + aoff + m * 2048 + k * 1024); } while (0)
#define PG8_LDB(dst, b, h) do { _Pragma("unroll") for (int n = 0; n < 2; ++n) _Pragma("unroll") for (int k = 0; k < 2; ++k) dst[n][k] = *(const LAS bf16x8*)(lds + PG8_SB(b, h) + boff + n * 2048 + k * 1024); } while (0)
#define PG8_MMA(ai, bj, At, Bt) do { __builtin_amdgcn_s_setprio(1); _Pragma("unroll") for (int m = 0; m < 4; ++m) _Pragma("unroll") for (int n = 0; n < 2; ++n) _Pragma("unroll") for (int k = 0; k < 2; ++k) \
        acc[ai][bj][m][n] = __builtin_amdgcn_mfma_f32_16x16x32_bf16(Bt[n][k], At[m][k], acc[ai][bj][m][n], 0, 0, 0); __builtin_amdgcn_s_setprio(0); } while (0)
#define PG8_WAIT_V(n) asm volatile("s_waitcnt vmcnt(" #n ")" ::: "memory")
#define PG8_WAIT_L(n) asm volatile("s_waitcnt lgkmcnt(" #n ")" ::: "memory")
#define PG8_BAR __builtin_amdgcn_s_barrier()
#define PG8_SCHED __builtin_amdgcn_sched_barrier(0)
    Unit cur, nxt; int ui = 0;
    if (!S.next(0, cur)) return;
    f32x4 acc[2][2][4][2];
#pragma unroll
    for (int a = 0; a < 2; ++a)
#pragma unroll
        for (int b = 0; b < 2; ++b)
#pragma unroll
            for (int m = 0; m < 4; ++m)
#pragma unroll
                for (int n = 0; n < 2; ++n) acc[a][b][m][n] = (f32x4){0.f, 0.f, 0.f, 0.f};
    bf16x8 At[4][2], B0[2][2], B1[2][2];
    const char* cA = (const char*)g.A + (size_t)cur.pm * tstep; const char* cB = (const char*)g.Bt + (size_t)cur.pn * tstep;
    PG8_STAGE(PG8_SB(0, 0), cB, voffB); PG8_STAGE(PG8_SA(0, 0), cA, voffA); PG8_STAGE(PG8_SB(0, 1), cB + hstep, voffB); PG8_STAGE(PG8_SA(0, 1), cA + hstep, voffA);
    if (wr == 1) PG8_BAR;
    PG8_WAIT_V(4); PG8_BAR;
    PG8_STAGE(PG8_SB(1, 0), cB + kstep, voffB); PG8_STAGE(PG8_SA(1, 0), cA + kstep, voffA); PG8_STAGE(PG8_SB(1, 1), cB + hstep + kstep, voffB);
    PG8_WAIT_V(6); PG8_BAR;
    for (;;) {
        const bool has_next = S.next(ui + 1, nxt);
        const char* nA = has_next ? (const char*)g.A + (size_t)nxt.pm * tstep : cA; const char* nB = has_next ? (const char*)g.Bt + (size_t)nxt.pn * tstep : cB;
        for (int t = 0; t < nt; t += 2) {
            const bool last = (t == nt - 2);
            const char* a1 = cA + (size_t)(t + 1) * kstep;
            const char* a2 = last ? nA : cA + (size_t)(t + 2) * kstep; const char* b2 = last ? nB : cB + (size_t)(t + 2) * kstep;
            const char* a3 = a2 + kstep; const char* b3 = b2 + kstep;
            PG8_LDB(B0, 0, 0); PG8_SCHED; PG8_LDA(At, 0, 0); PG8_STAGE(PG8_SA(1, 1), a1 + hstep, voffA);
            PG8_WAIT_L(8); PG8_BAR; PG8_WAIT_L(0); PG8_MMA(0, 0, At, B0); PG8_BAR; PG8_SCHED;
            PG8_LDB(B1, 0, 1); PG8_STAGE(PG8_SB(0, 0), b2, voffB);
            PG8_BAR; PG8_WAIT_L(0); PG8_MMA(0, 1, At, B1); PG8_BAR;
            PG8_LDA(At, 0, 1); PG8_STAGE(PG8_SA(0, 0), a2, voffA);
            PG8_BAR; PG8_WAIT_L(0); PG8_MMA(1, 0, At, B0); PG8_BAR; PG8_SCHED;
            PG8_STAGE(PG8_SB(0, 1), b2 + hstep, voffB);
            PG8_WAIT_V(6); PG8_BAR; PG8_MMA(1, 1, At, B1); PG8_BAR;
            PG8_LDB(B0, 1, 0); PG8_SCHED; PG8_LDA(At, 1, 0); PG8_STAGE(PG8_SA(0, 1), a2 + hstep, voffA);
            PG8_WAIT_L(8); PG8_BAR; PG8_WAIT_L(0); PG8_MMA(0, 0, At, B0); PG8_BAR; PG8_SCHED;
            PG8_LDB(B1, 1, 1); PG8_STAGE(PG8_SB(1, 0), b3, voffB);
            PG8_BAR; PG8_WAIT_L(0); PG8_MMA(0, 1, At, B1); PG8_BAR;
            PG8_LDA(At, 1, 1); PG8_STAGE(PG8_SA(1, 0), a3, voffA);
            PG8_BAR; PG8_WAIT_L(0); PG8_MMA(1, 0, At, B0); PG8_BAR; PG8_SCHED;
            PG8_STAGE(PG8_SB(1, 1), b3 + hstep, voffB);
            PG8_WAIT_V(6); PG8_BAR; PG8_MMA(1, 1, At, B1); PG8_BAR;
        }
        { int fr2 = fr, fq2 = fq; asm volatile("" : "+v"(fr2), "+v"(fq2)); E(acc, cur, wr, wc, fr2, fq2); }
        if (!has_next) break;
#pragma unroll
        for (int a = 0; a < 2; ++a)
#pragma unroll
            for (int b = 0; b < 2; ++b)
#pragma unroll
                for (int m = 0; m < 4; ++m)
#pragma unroll
                    for (int n = 0; n < 2; ++n) acc[a][b][m][n] = (f32x4){0.f, 0.f, 0.f, 0.f};
        cur = nxt; cA = nA; cB = nB; ++ui;
    }
    PG8_WAIT_V(0);
    if (wr == 0) PG8_BAR;
    PG8_BAR;
#undef PG8_SA
#undef PG8_SB
#undef PG8_STAGE
#undef PG8_LDA
#undef PG8_LDB
#undef PG8_MMA
#undef PG8_WAIT_V
#undef PG8_WAIT_L
#undef PG8_BAR
#undef PG8_SCHED
}
}

typedef f32x4 AccT[2][2][4][2];
DI u32x4 pack8(f32x4 a, f32x4 b) { u32x4 w; w.x = pk2(a[0], a[1]); w.y = pk2(a[2], a[3]); w.z = pk2(b[0], b[1]); w.w = pk2(b[2], b[3]); return w; }
DI size_t fragoff(int row, int kidx, int KS) { return (size_t)((((row >> 5) * KS + (kidx >> 4)) * 64 + (row & 31) + 32 * ((kidx >> 3) & 1)) * 8); }

DI void kt_store(unsigned char* sc, const u32x4 w, int fr, int fq, bf16_t* ktbase, int dbase, int sbase) {
    unsigned short* s16 = (unsigned short*)sc;
#pragma unroll
    for (int j = 0; j < 8; ++j) s16[(8 * fq + j) * 24 + fr] = (unsigned short)((w[j >> 1] >> (16 * (j & 1))) & 0xffffu);
    asm volatile("s_waitcnt lgkmcnt(0)" ::: "memory");
    const int L = fr + 16 * fq, fl = L >> 1, th = L & 1;
    const u32x4 r = *(const u32x4*)(sc + (fl * 24 + th * 8) * 2);
    asm volatile("s_waitcnt lgkmcnt(0)" ::: "memory");
    *(u32x4*)(ktbase + fragoff(dbase + fl, sbase + th * 8, 8)) = r;
}
struct EpiInN {
    static constexpr bool PERM = true;
    const Params* p; int S; unsigned char* smem;
    DI void operator()(const AccT& acc, const pg8::Unit& u, int wr, int wc, int fr, int fq) const {
        const int pn = u.pn;
        const int d0 = wc * 32 + 8 * fq;
        if (pn < 8) {
            bf16_t* dst = pn < 4 ? p->Qb : p->Kb; const int head = pn & 3;
#pragma unroll
            for (int ai = 0; ai < 2; ++ai)
#pragma unroll
                for (int m = 0; m < 4; ++m) {
                    const int row = u.pm * 256 + ai * 128 + wr * 64 + m * 16 + fr; const int pos = row % S; const int chunk = row >> 7, t = row & 127;
                    const f32x4 c0 = *(const f32x4*)(p->cosT + pos * 128 + d0), c1 = *(const f32x4*)(p->cosT + pos * 128 + d0 + 4);
                    const f32x4 s0 = *(const f32x4*)(p->sinT + pos * 128 + d0), s1 = *(const f32x4*)(p->sinT + pos * 128 + d0 + 4);
                    const f32x4 x10 = acc[ai][0][m][0], x11 = acc[ai][0][m][1], x20 = acc[ai][1][m][0], x21 = acc[ai][1][m][1];
                    const f32x4 o10 = x10 * c0 - x20 * s0, o11 = x11 * c1 - x21 * s1, o20 = x10 * s0 + x20 * c0, o21 = x11 * s1 + x21 * c1;
                    bf16_t* base = dst + (size_t)(chunk * 4 + head) * (128 * 256);
                    const u32x4 w1 = pack8(o10, o11), w2 = pack8(o20, o21);
                    *(u32x4*)(base + fragoff(t, d0, 16)) = w1;
                    *(u32x4*)(base + fragoff(t, d0 + 128, 16)) = w2;
                    if (pn >= 4) {
                        unsigned char* sc = smem + 131072 + (wr * 4 + wc) * 2048;
                        bf16_t* ktb = p->KbT + (size_t)(chunk * 4 + head) * (256 * 128);
                        kt_store(sc, w1, fr, fq, ktb, wc * 32, wr * 64 + m * 16);
                        kt_store(sc, w2, fr, fq, ktb, 128 + wc * 32, wr * 64 + m * 16);
                    }
                }
        } else if (pn < 12) {
            bf16_t* dst = pn < 10 ? p->Qa : p->Ka;
#pragma unroll
            for (int ai = 0; ai < 2; ++ai)
#pragma unroll
                for (int m = 0; m < 4; ++m) {
                    const int row = u.pm * 256 + ai * 128 + wr * 64 + m * 16 + fr; const int chunk = row >> 7, t = row & 127;
#pragma unroll
                    for (int bj = 0; bj < 2; ++bj) {
                        const int head = ((pn - 8) & 1) * 2 + bj;
                        bf16_t* base = dst + (size_t)(chunk * 4 + head) * (128 * 128);
                        const u32x4 w1 = pack8(acc[ai][bj][m][0], acc[ai][bj][m][1]);
                        *(u32x4*)(base + fragoff(t, d0, 8)) = w1;
                        if (pn >= 10) kt_store(smem + 131072 + (wr * 4 + wc) * 2048, w1, fr, fq, p->KaT + (size_t)(chunk * 4 + head) * (128 * 128), wc * 32, wr * 64 + m * 16);
                    }
                }
        } else {
#pragma unroll
            for (int ai = 0; ai < 2; ++ai)
#pragma unroll
                for (int m = 0; m < 4; ++m) {
                    const int row = u.pm * 256 + ai * 128 + wr * 64 + m * 16 + fr;
                    bf16_t* rp = p->E + (size_t)row * 4096 + (pn - 12) * 256 + d0;
#pragma unroll
                    for (int bj = 0; bj < 2; ++bj) *(u32x4*)(rp + bj * 128) = pack8(acc[ai][bj][m][0], acc[ai][bj][m][1]);
                }
        }
    }
};
struct EpiInT {
    static constexpr bool PERM = true;
    const Params* p; int S;
    DI void operator()(const AccT& acc, const pg8::Unit& u, int wr, int wc, int fr, int fq) const {
        const int pm = u.pm;
        const int s0 = wc * 32 + 8 * fq;
        bf16_t* dst = pm < 4 ? p->VaT : p->VbT; const int head = pm & 3;
#pragma unroll
        for (int ai = 0; ai < 2; ++ai)
#pragma unroll
            for (int bj = 0; bj < 2; ++bj) {
                const int chunk = u.pn * 2 + bj;
                bf16_t* base = dst + (size_t)(chunk * 4 + head) * (256 * 128);
#pragma unroll
                for (int m = 0; m < 4; ++m) { const int v = ai * 128 + wr * 64 + m * 16 + fr; *(u32x4*)(base + fragoff(v, s0, 8)) = pack8(acc[ai][bj][m][0], acc[ai][bj][m][1]); }
            }
    }
};
template <bool XB> struct EpiRes {
    static constexpr bool PERM = false;
    float* Y;
    const bf16_t* X;
    DI void operator()(const AccT& acc, const pg8::Unit& u, int wr, int wc, int fr, int fq) const {
        const int row0 = u.pm * 256 + wr * 64 + fr, col0 = u.pn * 256 + wc * 32 + 4 * fq;
#pragma unroll
        for (int ai = 0; ai < 2; ++ai) {
            f32x4 xv[4][2][2];
#pragma unroll
            for (int m = 0; m < 4; ++m)
#pragma unroll
                for (int bj = 0; bj < 2; ++bj)
#pragma unroll
                    for (int n = 0; n < 2; ++n) {
                        const size_t off = (size_t)(row0 + ai * 128 + m * 16) * DM + col0 + bj * 128 + n * 16;
                        if (XB) { const u32x2 xw = *(const u32x2*)(X + off); xv[m][bj][n] = (f32x4){bflo(xw.x), bfhi(xw.x), bflo(xw.y), bfhi(xw.y)}; }
                        else xv[m][bj][n] = *(const f32x4*)(Y + off);
                    }
#pragma unroll
            for (int m = 0; m < 4; ++m)
#pragma unroll
                for (int bj = 0; bj < 2; ++bj)
#pragma unroll
                    for (int n = 0; n < 2; ++n) {
                        const size_t off = (size_t)(row0 + ai * 128 + m * 16) * DM + col0 + bj * 128 + n * 16;
                        *(f32x4*)(Y + off) = xv[m][bj][n] * ALPHA + acc[ai][bj][m][n];
                    }
        }
    }
};
struct EpiB16 {
    static constexpr bool PERM = true;
    bf16_t* O; int ldc;
    DI void operator()(const AccT& acc, const pg8::Unit& u, int wr, int wc, int fr, int fq) const {
        const int row0 = u.pm * 256 + wr * 64 + fr, col0 = u.pn * 256 + wc * 32 + 8 * fq;
#pragma unroll
        for (int ai = 0; ai < 2; ++ai)
#pragma unroll
            for (int m = 0; m < 4; ++m) { bf16_t* rp = O + (size_t)(row0 + ai * 128 + m * 16) * ldc + col0;
#pragma unroll
                for (int bj = 0; bj < 2; ++bj) *(u32x4*)(rp + bj * 128) = pack8(acc[ai][bj][m][0], acc[ai][bj][m][1]); }
    }
};

DI void transpose_cvt(const float* W, bf16_t* WT, int K, int N, int tid) {
    const long total = (long)N * (K / 8);
    for (long i = (long)blockIdx.x * 512 + tid; i < total; i += (long)gridDim.x * 512) {
        const int n = (int)(i % N), kc = (int)(i / N);
        const float* w = W + (size_t)(kc * 8) * N + n;
        float v[8];
#pragma unroll
        for (int j = 0; j < 8; ++j) v[j] = w[(size_t)j * N];
        u32x4 o; o.x = pk2(v[0], v[1]); o.y = pk2(v[2], v[3]); o.z = pk2(v[4], v[5]); o.w = pk2(v[6], v[7]);
        *(u32x4*)(WT + (size_t)n * K + kc * 8) = o;
    }
}
DI void phase_prep(const Params& p, int tid) {
    const long gtid = (long)blockIdx.x * 512 + tid, gsz = (long)gridDim.x * 512;
    for (long i = gtid; i < 2L * NW * 128; i += gsz) {
        const int n = (int)(i % NW), kc = (int)((i / NW) % 128), l = (int)(i / ((long)NW * 128));
        int src; float sc = 1.f;
        if (n < NNORM) {
            if (n < 1024) src = 3088 + n;
            else if (n < 2048) { src = 4112 + (n - 1024); sc = 0.0625f; }
            else if (n < 2560) { src = n - 2048; sc = 0.08838834764831845f; }
            else if (n < 3072) src = 512 + (n - 2560);
            else if (n < 4096) src = 2048 + (n - 3072);
            else if (n < 5120) src = 6160 + (n - 4096);
            else if (n < 6144) src = 7184 + (n - 5120);
            else src = 8208 + (n - 6144);
        } else {
            const int m = n - NNORM;
            if (m < 1024) src = 1024 + m;
            else src = 5136 + (m - 1024);
        }
        const float* w = p.w_in + (size_t)l * DM * NIN + (size_t)(kc * 8) * NIN + src;
        float v[8];
#pragma unroll
        for (int j = 0; j < 8; ++j) v[j] = w[(size_t)j * NIN] * sc;
        u32x4 o; o.x = pk2(v[0], v[1]); o.y = pk2(v[2], v[3]); o.z = pk2(v[4], v[5]); o.w = pk2(v[6], v[7]);
        *(u32x4*)(p.WinT + ((size_t)l * NW + n) * DM + kc * 8) = o;
    }
    for (int l = 0; l < 2; ++l) {
        transpose_cvt(p.w_o + (size_t)l * DM * DM, p.WoT + (size_t)l * DM * DM, DM, DM, tid);
        transpose_cvt(p.w_up + (size_t)l * DM * NUP, p.WupT + (size_t)l * NUP * DM, DM, NUP, tid);
        transpose_cvt(p.w_down + (size_t)l * DFF * DM, p.WdT + (size_t)l * DM * DFF, DFF, DM, tid);
    }
    for (long i = gtid; i < 2L * 16 * 1024; i += gsz) {
        const int k = (int)(i & 1023), gi = (int)((i >> 10) & 15), l = (int)(i >> 14);
        p.WgT[i] = (bf16_t)f2bf(p.w_in[(size_t)l * DM * NIN + (size_t)k * NIN + 3072 + gi]);
    }
    for (long i = gtid; i < 4096L * 128; i += gsz) {
        const int pos = (int)(i >> 7), j = (int)(i & 127);
        const double inv = pow(10000.0, -(double)j / 128.0);
        const double ang = (double)pos * inv;
        const float c = (float)cos(ang), s = (float)sin(ang);
        p.cosT[i] = c; p.sinT[i] = s;
    }
}

DI void phase_ln(const void* srcv, const int srcmode  , const bf16_t* xres,
                 const float* g, const float* b, float* dstf, bf16_t* dstb, int ntok, int tid,
                 unsigned char* smem, const float* wg  , const float* bias16, float* gpre) {
    const int wid = tid >> 6, lane = tid & 63;
    float* WgT = (float*)smem;
    if (wg) {
        for (int idx = tid; idx < 4096; idx += 512) {
            const int k = idx >> 2, j4 = idx & 3;
            const f32x4 w = *(const f32x4*)(wg + (size_t)k * NIN + 3072 + j4 * 4);
#pragma unroll
            for (int jj = 0; jj < 4; ++jj) WgT[(j4 * 4 + jj) * 1024 + k] = w[jj];
        }
        __syncthreads();
    }
    const int rstride = gridDim.x * 8;
    f32x4 gvv[4], bvv[4];
#pragma unroll
    for (int q = 0; q < 4; ++q) { gvv[q] = *(const f32x4*)(g + q * 256 + lane * 4); bvv[q] = *(const f32x4*)(b + q * 256 + lane * 4); }
    u32x4 nx[4];
#define LN_LOAD(r_) do { _Pragma("unroll") for (int q = 0; q < 4; ++q) { \
        if (srcmode) { const u32x2 t_ = *(const u32x2*)((const bf16_t*)srcv + (size_t)(r_) * DM + q * 256 + lane * 4); \
                       const u32x2 u_ = *(const u32x2*)(xres + (size_t)(r_) * DM + q * 256 + lane * 4); nx[q] = (u32x4){t_.x, t_.y, u_.x, u_.y}; } \
        else nx[q] = *(const u32x4*)((const float*)srcv + (size_t)(r_) * DM + q * 256 + lane * 4); } } while (0)
    {
        const int r0 = blockIdx.x * 8 + wid;
        if (r0 < ntok) LN_LOAD(r0);
    }
    for (int row = blockIdx.x * 8 + wid; row < ntok; row += rstride) {
        f32x4 v[4]; float s = 0.f;
#pragma unroll
        for (int q = 0; q < 4; ++q) {
            const u32x4 rw = nx[q];
            v[q] = srcmode ? (f32x4){bflo(rw.x) + ALPHA * bflo(rw.z), bfhi(rw.x) + ALPHA * bfhi(rw.z), bflo(rw.y) + ALPHA * bflo(rw.w), bfhi(rw.y) + ALPHA * bfhi(rw.w)}
                           : __builtin_bit_cast(f32x4, rw);
            s += v[q][0] + v[q][1] + v[q][2] + v[q][3];
        }
        if (row + rstride < ntok) LN_LOAD(row + rstride);
#pragma unroll
        for (int o = 32; o >= 1; o >>= 1) s += __shfl_xor(s, o);
        const float mu = s * (1.f / 1024.f);
        float ss = 0.f;
#pragma unroll
        for (int q = 0; q < 4; ++q) { v[q] = v[q] - mu; ss += v[q][0] * v[q][0] + v[q][1] * v[q][1] + v[q][2] * v[q][2] + v[q][3] * v[q][3]; }
#pragma unroll
        for (int o = 32; o >= 1; o >>= 1) ss += __shfl_xor(ss, o);
        const float rstd = rsqrtf(ss * (1.f / 1024.f) + LN_EPS);
#pragma unroll
        for (int q = 0; q < 4; ++q) {
            const f32x4 y = v[q] * rstd * gvv[q] + bvv[q];
            v[q] = y;
            if (dstf) *(f32x4*)(dstf + (size_t)row * DM + q * 256 + lane * 4) = y;
            u32x2 w; w.x = pk2(y[0], y[1]); w.y = pk2(y[2], y[3]);
            if (dstb) *(u32x2*)(dstb + (size_t)row * DM + q * 256 + lane * 4) = w;
        }
        if (wg) {
            float acc[16];
#pragma unroll
            for (int gi = 0; gi < 16; ++gi) {
                float a = 0.f;
#pragma unroll
                for (int q = 0; q < 4; ++q) { const f32x4 w = *(const f32x4*)(WgT + gi * 1024 + q * 256 + lane * 4); a += v[q][0] * w[0] + v[q][1] * w[1] + v[q][2] * w[2] + v[q][3] * w[3]; }
                acc[gi] = a;
            }
#pragma unroll
            for (int st = 0; st < 4; ++st) {
                const int half = 8 >> st; const bool up = (lane >> st) & 1;
#pragma unroll
                for (int i = 0; i < 8; ++i) if (i < half) {
                    const float send = up ? acc[i] : acc[i + half];
                    const float keep = up ? acc[i + half] : acc[i];
                    acc[i] = keep + __shfl_xor(send, 1 << st);
                }
            }
            float r = acc[0];
            r += __shfl_xor(r, 16); r += __shfl_xor(r, 32);
            const int gidx = ((lane & 1) << 3) | (((lane >> 1) & 1) << 2) | (((lane >> 2) & 1) << 1) | ((lane >> 3) & 1);
            if (lane < 16) gpre[(size_t)row * 16 + gidx] = r + bias16[gidx];
        }
    }
}

DI void phase_gscan(const Params& p, const float* gpre, int nchunks, int tid) {
    const int wid = tid >> 6, lane = tid & 63;
    const int tstride = gridDim.x * 8, ntask = nchunks * 8;
    float ni0 = 0.f, nf0 = 0.f, ni1 = 0.f, nf1 = 0.f;
#define GS_LOAD(task_) do { const int ch_ = (task_) >> 3, dir_ = ((task_) >> 2) & 1, head_ = (task_) & 3; \
        const int q0_ = dir_ ? 127 - 2 * lane : 2 * lane, q1_ = dir_ ? 126 - 2 * lane : 2 * lane + 1; \
        const float* r0_ = gpre + (size_t)(ch_ * 128 + q0_) * 16 + dir_ * 8 + head_; const float* r1_ = gpre + (size_t)(ch_ * 128 + q1_) * 16 + dir_ * 8 + head_; \
        ni0 = r0_[0]; nf0 = r0_[4]; ni1 = r1_[0]; nf1 = r1_[4]; } while (0)
    { const int t0 = blockIdx.x * 8 + wid; if (t0 < ntask) GS_LOAD(t0); }
    for (int task = blockIdx.x * 8 + wid; task < ntask; task += tstride) {
        const int ch = task >> 3, dir = (task >> 2) & 1, head = task & 3;
        const int p0 = dir ? 127 - 2 * lane : 2 * lane, p1 = dir ? 126 - 2 * lane : 2 * lane + 1;
        const float i0 = ni0, f0 = nf0, i1 = ni1, f1 = nf1;
        if (task + tstride < ntask) GS_LOAD(task + tstride);
        const float l0 = fminf(f0, 0.f) - log1pf(__expf(-fabsf(f0))), l1 = fminf(f1, 0.f) - log1pf(__expf(-fabsf(f1)));
        const float pair = l0 + l1;
        float inc = pair;
#pragma unroll
        for (int d = 1; d < 64; d <<= 1) { const float t = __shfl_up(inc, d); if (lane >= d) inc += t; }
        const float exc = inc - pair;
        const float c0 = exc + l0, c1 = exc + pair;
        const float b0 = i0 - c0, b1 = i1 - c1;
        float mx = fmaxf(b0, b1);
#pragma unroll
        for (int d = 1; d < 64; d <<= 1) { const float t = __shfl_up(mx, d); if (lane >= d) mx = fmaxf(mx, t); }
        float mexc = __shfl_up(mx, 1); if (lane == 0) mexc = -3.0e38f;
        const float pm0 = fmaxf(mexc, b0), pm1 = fmaxf(pm0, b1);
        float* gp = p.gates + ((size_t)(ch * 2 + dir) * 4 + head) * 384;
        gp[p0] = b0; gp[128 + p0] = pm0; gp[256 + p0] = c0;
        gp[p1] = b1; gp[128 + p1] = pm1; gp[256 + p1] = c1;
    }
#undef GS_LOAD
}

DI void phase_gates2(const Params& p, unsigned char* smem, int layer, const bf16_t* xin, int nchunks, int tid) {
    const int wid = tid >> 6, lane = tid & 63, r16 = lane & 15, kq = lane >> 4;
    float* pre = (float*)smem;
    const bf16_t* wgt = p.WgT + (size_t)layer * 16 * DM;
    for (int ch = blockIdx.x; ch < nchunks; ch += gridDim.x) {
        {
            const bf16_t* ap = xin + (size_t)(ch * 128 + wid * 16 + r16) * DM + kq * 8;
            const bf16_t* bp = wgt + (size_t)r16 * DM + kq * 8;
            f32x4 acc = {0.f, 0.f, 0.f, 0.f};
#pragma unroll 8
            for (int ks = 0; ks < 32; ++ks) {
                const bf16x8 av = *(const bf16x8*)(ap + ks * 32), bv = *(const bf16x8*)(bp + ks * 32);
                acc = __builtin_amdgcn_mfma_f32_16x16x32_bf16(av, bv, acc, 0, 0, 0);
            }
            const float bb = p.b_if[layer * 16 + r16];
#pragma unroll
            for (int r = 0; r < 4; ++r) pre[(wid * 16 + kq * 4 + r) * 17 + r16] = acc[r] + bb;
        }
        __syncthreads();
        {
            const int dir = wid >> 2, head = wid & 3;
            const int p0 = dir ? 127 - 2 * lane : 2 * lane, p1 = dir ? 126 - 2 * lane : 2 * lane + 1;
            const float i0 = pre[p0 * 17 + dir * 8 + head], f0 = pre[p0 * 17 + dir * 8 + 4 + head];
            const float i1 = pre[p1 * 17 + dir * 8 + head], f1 = pre[p1 * 17 + dir * 8 + 4 + head];
            const float l0 = fminf(f0, 0.f) - log1pf(__expf(-fabsf(f0))), l1 = fminf(f1, 0.f) - log1pf(__expf(-fabsf(f1)));
            const float pair = l0 + l1;
            float inc = pair;
#pragma unroll
            for (int d = 1; d < 64; d <<= 1) { const float t = __shfl_up(inc, d); if (lane >= d) inc += t; }
            const float exc = inc - pair;
            const float c0 = exc + l0, c1 = exc + pair;
            const float b0 = i0 - c0, b1 = i1 - c1;
            float mx = fmaxf(b0, b1);
#pragma unroll
            for (int d = 1; d < 64; d <<= 1) { const float t = __shfl_up(mx, d); if (lane >= d) mx = fmaxf(mx, t); }
            float mexc = __shfl_up(mx, 1); if (lane == 0) mexc = -3.0e38f;
            const float pm0 = fmaxf(mexc, b0), pm1 = fmaxf(pm0, b1);
            float* gp = p.gates + ((size_t)(ch * 2 + dir) * 4 + head) * 384;
            gp[p0] = b0; gp[128 + p0] = pm0; gp[256 + p0] = c0;
            gp[p1] = b1; gp[128 + p1] = pm1; gp[256 + p1] = c1;
        }
        __syncthreads();
    }
}

DI void phase_merge(const Params& p, int layer, int ntok, int tid) {
    const int wid = tid >> 6, lane = tid & 63;
    const int ch0 = lane * 16;
    const int rstride = gridDim.x * 8;
    float gav[16], gbv[16];
#pragma unroll
    for (int j = 0; j < 16; j += 4) {
        const f32x4 t0 = *(const f32x4*)(p.g_a + layer * DM + ch0 + j), t1 = *(const f32x4*)(p.g_b + layer * DM + ch0 + j);
#pragma unroll
        for (int k = 0; k < 4; ++k) { gav[j + k] = t0[k]; gbv[j + k] = t1[k]; }
    }
    u32x4 pre[8][2];
#define MERGE_LOAD(r) do { \
        const u32x4* a0 = (const u32x4*)(p.H0 + (size_t)(r) * DM + ch0); const u32x4* a1 = (const u32x4*)(p.H1 + (size_t)(r) * DM + ch0); \
        const u32x4* b0 = (const u32x4*)(p.H2 + (size_t)(r) * DM + ch0); const u32x4* b1 = (const u32x4*)(p.H3 + (size_t)(r) * DM + ch0); \
        const u32x4* e = (const u32x4*)(p.E + (size_t)(r) * 4096 + ch0); \
        _Pragma("unroll") for (int q = 0; q < 2; ++q) { pre[0][q] = a0[q]; pre[1][q] = a1[q]; pre[2][q] = b0[q]; pre[3][q] = b1[q]; pre[4][q] = e[q]; pre[5][q] = e[128 + q]; pre[6][q] = e[256 + q]; pre[7][q] = e[384 + q]; } } while (0)
    { const int r0 = blockIdx.x * 8 + wid; if (r0 < ntok) MERGE_LOAD(r0); }
    for (int row = blockIdx.x * 8 + wid; row < ntok; row += rstride) {
        float ha[16], hb[16], oa[16], gb[16], ma[16], mb[16];
        {
            u32x4 cur[8][2];
#pragma unroll
            for (int i = 0; i < 8; ++i) { cur[i][0] = pre[i][0]; cur[i][1] = pre[i][1]; }
            if (row + rstride < ntok) MERGE_LOAD(row + rstride);
#pragma unroll
            for (int q = 0; q < 2; ++q) {
                const u32x4 x0 = cur[0][q], x1 = cur[1][q], y0 = cur[2][q], y1 = cur[3][q], eo = cur[4][q], eg = cur[5][q], em = cur[6][q], en = cur[7][q];
#pragma unroll
                for (int j = 0; j < 4; ++j) {
                    ha[q * 8 + 2 * j] = bflo(x0[j]) + bflo(x1[j]); ha[q * 8 + 2 * j + 1] = bfhi(x0[j]) + bfhi(x1[j]);
                    hb[q * 8 + 2 * j] = bflo(y0[j]) + bflo(y1[j]); hb[q * 8 + 2 * j + 1] = bfhi(y0[j]) + bfhi(y1[j]);
                    oa[q * 8 + 2 * j] = bflo(eo[j]); oa[q * 8 + 2 * j + 1] = bfhi(eo[j]);
                    gb[q * 8 + 2 * j] = bflo(eg[j]); gb[q * 8 + 2 * j + 1] = bfhi(eg[j]);
                    ma[q * 8 + 2 * j] = bflo(em[j]); ma[q * 8 + 2 * j + 1] = bfhi(em[j]);
                    mb[q * 8 + 2 * j] = bflo(en[j]); mb[q * 8 + 2 * j + 1] = bfhi(en[j]);
                }
            }
        }
        float sa = 0.f, sb = 0.f;
#pragma unroll
        for (int j = 0; j < 16; ++j) { ha[j] *= sigmoidf_(oa[j]); sa += ha[j]; sb += hb[j]; }
#pragma unroll
        for (int o = 8; o >= 1; o >>= 1) { sa += __shfl_xor(sa, o); sb += __shfl_xor(sb, o); }
        const float mua = sa * (1.f / 256.f), mub = sb * (1.f / 256.f);
        float va = 0.f, vb = 0.f;
#pragma unroll
        for (int j = 0; j < 16; ++j) { ha[j] -= mua; hb[j] -= mub; va += ha[j] * ha[j]; vb += hb[j] * hb[j]; }
#pragma unroll
        for (int o = 8; o >= 1; o >>= 1) { va += __shfl_xor(va, o); vb += __shfl_xor(vb, o); }
        const float ra = rsqrtf(va * (1.f / 256.f) + LN_EPS), rb = rsqrtf(vb * (1.f / 256.f) + LN_EPS);
        unsigned ow[8];
#pragma unroll
        for (int j = 0; j < 16; j += 2) {
            float r[2];
#pragma unroll
            for (int k = 0; k < 2; ++k) {
                const float ya = ha[j + k] * ra * gav[j + k];
                const float yb = hb[j + k] * rb * gbv[j + k] * (gb[j + k] * sigmoidf_(gb[j + k]));
                r[k] = sigmoidf_(ma[j + k]) * ya + sigmoidf_(mb[j + k]) * yb;
            }
            ow[j >> 1] = pk2(r[0], r[1]);
        }
        u32x4* op = (u32x4*)(p.merged + (size_t)row * DM + ch0);
        op[0] = (u32x4){ow[0], ow[1], ow[2], ow[3]}; op[1] = (u32x4){ow[4], ow[5], ow[6], ow[7]};
    }
}

DI float gelu_tanh(float x) {
    const float u = 0.7978845608028654f * (x + 0.044715f * x * x * x);
    const float e = __expf(2.f * u);
    const float th = 1.f - 2.f * frcp(e + 1.f);
    return 0.5f * x * (1.f + th);
}
DI void phase_conv(const Params& p, int layer, int ntok, int S, int tid) {
    const float* cw = p.conv_w + (size_t)layer * 3 * NUP; const float* cbias = p.conv_b + (size_t)layer * NUP;
    const int wid = tid >> 6, lane = tid & 63;
    constexpr int SEG = 16, NCW = 11;
    const int ntask = NCW * (ntok / SEG);
    for (int task = blockIdx.x * 8 + wid; task < ntask; task += gridDim.x * 8) {
        const int cwv = task % NCW, seg = task / NCW;
        const int c = (cwv * 64 + lane) * 4;
        const int t0 = seg * SEG, pos0 = t0 % S;
        const f32x4 wv0 = *(const f32x4*)(cw + c), wv1 = *(const f32x4*)(cw + NUP + c), wv2 = *(const f32x4*)(cw + 2 * NUP + c), bv = *(const f32x4*)(cbias + c);
        const f32x4 wg0 = *(const f32x4*)(cw + DFF + c), wg1 = *(const f32x4*)(cw + NUP + DFF + c), wg2 = *(const f32x4*)(cw + 2 * NUP + DFF + c), bg = *(const f32x4*)(cbias + DFF + c);
        const bf16_t* hv = p.hu + (size_t)t0 * NUP + c; const bf16_t* hg = hv + DFF;
        bf16_t* op = p.ff + (size_t)t0 * DFF + c;
        const u32x2 z = {0u, 0u};
        u32x2 rv[SEG + 2], rg[SEG + 2];
        rv[0] = pos0 > 0 ? *(const u32x2*)(hv - NUP) : z; rg[0] = pos0 > 0 ? *(const u32x2*)(hg - NUP) : z;
#pragma unroll
        for (int i = 0; i < SEG; ++i) { rv[i + 1] = *(const u32x2*)(hv + (size_t)i * NUP); rg[i + 1] = *(const u32x2*)(hg + (size_t)i * NUP); }
        { const bool hn = (pos0 + SEG - 1) < S - 1; rv[SEG + 1] = hn ? *(const u32x2*)(hv + (size_t)SEG * NUP) : z; rg[SEG + 1] = hn ? *(const u32x2*)(hg + (size_t)SEG * NUP) : z; }
#pragma unroll
        for (int i = 0; i < SEG; ++i) {
            const u32x2 pv = rv[i], cv = rv[i + 1], nv = rv[i + 2], pg = rg[i], cg = rg[i + 1], ng = rg[i + 2];
            const f32x4 pvf = {bflo(pv.x), bfhi(pv.x), bflo(pv.y), bfhi(pv.y)}, cvf = {bflo(cv.x), bfhi(cv.x), bflo(cv.y), bfhi(cv.y)}, nvf = {bflo(nv.x), bfhi(nv.x), bflo(nv.y), bfhi(nv.y)};
            const f32x4 pgf = {bflo(pg.x), bfhi(pg.x), bflo(pg.y), bfhi(pg.y)}, cgf = {bflo(cg.x), bfhi(cg.x), bflo(cg.y), bfhi(cg.y)}, ngf = {bflo(ng.x), bfhi(ng.x), bflo(ng.y), bfhi(ng.y)};
            const f32x4 val = wv0 * pvf + wv1 * cvf + wv2 * nvf + bv;
            const f32x4 gat = wg0 * pgf + wg1 * cgf + wg2 * ngf + bg;
            u32x2 o; o.x = pk2(gelu_tanh(gat[0]) * val[0], gelu_tanh(gat[1]) * val[1]); o.y = pk2(gelu_tanh(gat[2]) * val[2], gelu_tanh(gat[3]) * val[3]);
            *(u32x2*)(op + (size_t)i * DFF) = o;
        }
    }
}

#define BAR_LDS() do { asm volatile("s_waitcnt lgkmcnt(0)" ::: "memory"); __builtin_amdgcn_s_barrier(); asm volatile("" ::: "memory"); } while (0)
#define BAR_ALL() do { asm volatile("s_waitcnt vmcnt(0) lgkmcnt(0)" ::: "memory"); __builtin_amdgcn_s_barrier(); asm volatile("" ::: "memory"); } while (0)
template <int DK, bool ML>
DI void mixer_item(const int tid_in, unsigned char* smem, int S, int nch, int seq, int head, int dir, int split,
                   const bf16_t* Qg, const bf16_t* Kg, const bf16_t* KTg, const bf16_t* VTg, bf16_t* Hout, const float* gates, float lgv) {
    constexpr int KS = DK / 16, NST = DK / 128, NKP = DK * 16 / 512;
    int tid = tid_in; asm volatile("" : "+v"(tid));
    const int wid = __builtin_amdgcn_readfirstlane(tid >> 6), lane = tid & 63, l31 = lane & 31, hh = lane >> 5;
    const int vt = wid >> 2, tb = vt ? 7 - wid : wid;
#define MK_BASES(lo, to) \
    const unsigned l31x = ((lo) >> 4) & 31u, hhx = (lo) >> 9; \
    const unsigned a_ks = (unsigned)(vt * 2 * KS * 1024) + (lo); \
    const unsigned a_vt = (unsigned)(65536 + vt * 8 * 1024) + (lo); \
    const unsigned a_cs = (unsigned)(81920 + vt * KS * 1024) + (lo); \
    const unsigned a_ps = (unsigned)(114688 + tb * 8 * 1024) + (lo); \
    const unsigned a_psw = (unsigned)(114688 + (tb * 8 + vt * 4) * 1024) + l31x * 16 + 8 * hhx; \
    const unsigned a_csw = (unsigned)(81920 + (vt * KS + tb * 2) * 1024) + l31x * 16 + 8 * hhx; \
    const unsigned a_cp = (to); \
    const unsigned a_tv = (unsigned)(147456 + tb * 128) + l31x * 4; \
    const unsigned a_sv = (unsigned)(147456 + vt * 256) + 16 * hhx; \
    const unsigned a_hv = 147456u + hhx * 32; \
    const unsigned a_th = 147456u + ((to) >> 2);
    LAS unsigned char* const L = (LAS unsigned char*)smem;
#define LDSB(addr, off) (L + (addr) + (off))
#define LDG(T, base, off) (*(const T*)((const char*)(base) + (unsigned)(off)))
#define KDMA(Kptr, i) __builtin_amdgcn_global_load_lds((const unsigned*)((const char*)(Kptr) + (unsigned)(tofs + (i) * 8192)), (LAS unsigned*)(L + (unsigned)wid * 1024u + (i) * 8192), 16, 0, 0)
    {
        unsigned lo0 = lane * 16, to0 = tid * 16; asm volatile("" : "+v"(lo0), "+v"(to0));
        MK_BASES(lo0, to0)
        (void)a_ks; (void)a_vt; (void)a_cs; (void)a_ps; (void)a_psw; (void)a_csw; (void)a_tv; (void)a_sv; (void)a_hv;
        for (int i = 0; i < 64 * DK * 2 / 16 / 512; ++i) *(LAS u32x4*)LDSB(a_cp, 81920 + i * 8192) = (u32x4){0u, 0u, 0u, 0u};
        if (tid < 128) *(LAS float*)LDSB(a_th, 7 * 512) = 0.f;
        if (ML) {
#pragma unroll
            for (int i = 0; i < 3; ++i) {
                const unsigned ones = (i == 0 && (lo0 & (31u * 16u)) == 0u) ? 0x3F803F80u : 0u;
                *(LAS u32x4*)LDSB(a_cp, 32768 + i * 8192) = (u32x4){ones, ones, ones, ones};
            }
        }
    }
    f32x16 stC[NST];
    f32x16 stX;
#pragma unroll
    for (int r = 0; r < 16; ++r) stX[r] = 0.f;
#pragma unroll
    for (int i = 0; i < NST; ++i)
#pragma unroll
        for (int r = 0; r < 16; ++r) stC[i][r] = 0.f;
    float m = 0.f;
    const int last = dir ? 0 : 127;
    const int c0 = dir ? nch - 1 : 0;
    const size_t blk0 = ((size_t)seq * nch + c0) * 4 + head;
    bf16x8 qf[KS];
    u32x4 vtr[2];
    u32x4 kst[NKP];
    bf16x8 qfn[KS];
    float g_b = 0.f, g_pm = 0.f, g_cb = 0.f, g_pml = 0.f, g_cbl = 0.f;
    {
        unsigned lofs = lane * 16, tofs = tid * 16; asm volatile("" : "+v"(lofs), "+v"(tofs));
        const bf16_t* Kf = Kg + blk0 * (size_t)(128 * DK);
        if (ML) {
#pragma unroll
            for (int i = 0; i < NKP; ++i) kst[i] = LDG(u32x4, Kf, tofs + i * 8192);
        } else {
#pragma unroll
            for (int i = 0; i < NKP; ++i) KDMA(Kf, i);
        }
        const bf16_t* Qf = Qg + blk0 * (size_t)(128 * DK);
#pragma unroll
        for (int ks = 0; ks < KS; ++ks) qf[ks] = LDG(bf16x8, Qf + tb * KS * 512, lofs + ks * 1024);
        const bf16_t* VTf = VTg + blk0 * (size_t)(256 * 128) + split * (2 * 8 * 512);
#pragma unroll
        for (int i = 0; i < 2; ++i) vtr[i] = LDG(u32x4, VTf, tofs + i * 8192);
        if (ML) {
            const float* gp = gates + (((size_t)seq * nch + c0) * 2 + dir) * 4 * 384 + head * 384;
            g_pml = gp[128 + last]; g_cbl = gp[256 + last];
            if (tid < 128) { g_b = gp[tid]; g_pm = gp[128 + tid]; g_cb = gp[256 + tid]; }
        }
    }
    for (int ci = 0; ci < nch; ++ci) {
        const int c = dir ? nch - 1 - ci : ci;
        const bool has_next = ci + 1 < nch;
        unsigned lofs = lane * 16, tofs = tid * 16; asm volatile("" : "+v"(lofs), "+v"(tofs));
        float lgl = lgv; asm volatile("" : "+v"(lgl));
        const float rstep = ML ? 1.f : __expf(dir ? lgl : -lgl);
        MK_BASES(lofs, tofs)
        const int cn = dir ? c - 1 : c + 1;
        const size_t blk = ((size_t)seq * nch + c) * 4 + head;
        const size_t blkn = ((size_t)seq * nch + (has_next ? cn : c)) * 4 + head;
        const bf16_t* KTf = KTg + blk * (size_t)(DK * 128);
        const bf16_t* Kfn = Kg + blkn * (size_t)(128 * DK);
        if (ML) {
#pragma unroll
            for (int i = 0; i < NKP; ++i) *(LAS u32x4*)LDSB(a_cp, i * 8192) = kst[i];
        }
#pragma unroll
        for (int i = 0; i < 2; ++i) *(LAS u32x4*)LDSB(a_cp, 65536 + i * 8192) = vtr[i];
        float dec, m_new = 0.f;
        if (ML) {
            const float Ml = fmaxf(m, g_pml);
            dec = __expf(m - Ml); m_new = g_cbl + Ml;
            if (tid < 128) {
                const float M = fmaxf(m, g_pm);
                *(LAS float*)LDSB(a_th, 0) = g_b * 1.44269504089f; *(LAS float*)LDSB(a_th, 512) = M * 1.44269504089f; *(LAS float*)LDSB(a_th, 1024) = __expf(m - M);
                *(LAS float*)LDSB(a_th, 1536) = __expf(-g_cb - M); *(LAS float*)LDSB(a_th, 2048) = __expf(g_b - Ml); *(LAS float*)LDSB(a_th, 2560) = 0.f;
            }
        } else {
            dec = __expf(lgv * 128.f);
            if (ci == 0 && tid < 128) { *(LAS float*)LDSB(a_th, 1024) = __expf(lgv * (float)(dir ? (128 - tid) : (tid + 1))); *(LAS float*)LDSB(a_th, 2048) = __expf(lgv * (float)(dir ? tid : (127 - tid))); }
        }
        BAR_ALL();
        {
            float rsp = 0.f;
            const int t = tb * 32 + (int)l31x;
            const float Mtt = ML ? *(const LAS float*)LDSB(a_tv, 512) : 0.f;
#pragma unroll
            for (int sbi = 0; sbi < 2; ++sbi) {
                const int sb = vt * 2 + sbi;
                if (dir ? (sb < tb) : (sb > tb)) continue;
                f32x16 acc;
#pragma unroll
                for (int r = 0; r < 16; ++r) acc[r] = 0.f;
                {
                    bf16x8 fb[2][4];
#pragma unroll
                    for (int j = 0; j < 4; ++j) fb[0][j] = *(const LAS bf16x8*)LDSB(a_ks, (sbi * KS + j) * 1024);
#pragma unroll
                    for (int g = 0; g < KS / 4; ++g) {
                        if (g + 1 < KS / 4) {
#pragma unroll
                            for (int j = 0; j < 4; ++j) fb[(g + 1) & 1][j] = *(const LAS bf16x8*)LDSB(a_ks, (sbi * KS + (g + 1) * 4 + j) * 1024);
                        }
                        __builtin_amdgcn_sched_barrier(0);
#pragma unroll
                        for (int j = 0; j < 4; ++j) acc = MFMA32(fb[g & 1][j], qf[g * 4 + j], acc);
                        __builtin_amdgcn_sched_barrier(0);
                    }
                }
                const int mb = dir ? (t - sb * 32 - 4 * (int)hhx) : (sb * 32 + 4 * (int)hhx - t);
                float wk = 0.f, wr = 0.f;
                if (!ML) { wk = __expf(-lgl * (float)mb); wr = rstep; }
#pragma unroll
                for (int q = 0; q < 4; ++q) {
                    float v[4];
                    f32x4 bs4 = {0.f, 0.f, 0.f, 0.f};
                    if (ML) bs4 = *(const LAS f32x4*)LDSB(a_sv, (sbi * 32 + 8 * q) * 4);
#pragma unroll
                    for (int jj = 0; jj < 4; ++jj) {
                        const int k = 8 * q + jj;
                        const bool ok = mb <= (dir ? k : -k);
                        const float w = ML ? __builtin_amdgcn_exp2f(bs4[jj] - Mtt) : wk;
                        v[jj] = ok ? acc[q * 4 + jj] * w : 0.f;
                        rsp += v[jj];
                        if (!ML) wk *= wr;
                    }
                    if (!ML) { wk *= wr; wk *= wr; wk *= wr; wk *= wr; }
                    u32x2 o; o.x = pk2(v[0], v[1]); o.y = pk2(v[2], v[3]);
                    *(LAS u32x2*)LDSB(a_psw, (sbi * 2 + (q >> 1)) * 1024 + (q & 1) * 512) = o;
                }
            }
            (void)rsp;
        }
        BAR_LDS();
        if (has_next) {
            if (ML) {
#pragma unroll
                for (int i = 0; i < NKP; ++i) kst[i] = LDG(u32x4, Kfn, tofs + i * 8192);
                const bf16_t* Qfn = Qg + blkn * (size_t)(128 * DK);
#pragma unroll
                for (int ks = 0; ks < KS; ++ks) qfn[ks] = LDG(bf16x8, Qfn + tb * KS * 512, lofs + ks * 1024);
                const bf16_t* VTfn = VTg + blkn * (size_t)(256 * 128) + split * (2 * 8 * 512);
#pragma unroll
                for (int i = 0; i < 2; ++i) vtr[i] = LDG(u32x4, VTfn, tofs + i * 8192);
                const float* gp = gates + (((size_t)seq * nch + cn) * 2 + dir) * 4 * 384 + head * 384;
                g_pml = gp[128 + last]; g_cbl = gp[256 + last];
                if (tid < 128) { g_b = gp[tid]; g_pm = gp[128 + tid]; g_cb = gp[256 + tid]; }
            } else {
#pragma unroll
                for (int i = 0; i < NKP; ++i) KDMA(Kfn, i);
            }
        }
        bf16x8 kt[8];
        {
            f32x16 a1, a2;
#pragma unroll
            for (int r = 0; r < 16; ++r) { a1[r] = 0.f; a2[r] = 0.f; }
            f32x16 a1x, a2x;
#pragma unroll
            for (int r = 0; r < 16; ++r) { a1x[r] = 0.f; a2x[r] = 0.f; }
            {
#pragma unroll
                for (int g = 0; g < 4; ++g) {
                    if (dir ? (g < tb) : (g > tb)) continue;
                    const bf16x8 fa0 = *(const LAS bf16x8*)LDSB(a_vt, (g * 2) * 1024), fa1 = *(const LAS bf16x8*)LDSB(a_vt, (g * 2 + 1) * 1024);
                    const bf16x8 fp0 = *(const LAS bf16x8*)LDSB(a_ps, (g * 2) * 1024), fp1 = *(const LAS bf16x8*)LDSB(a_ps, (g * 2 + 1) * 1024);
                    a1 = MFMA32(fa0, fp0, a1); a1 = MFMA32(fa1, fp1, a1);
                    if (ML) {
                        const bf16x8 fx0 = *(const LAS bf16x8*)(L + lofs + 32768u + (g * 2) * 1024), fx1 = *(const LAS bf16x8*)(L + lofs + 32768u + (g * 2 + 1) * 1024);
                        a1x = MFMA32(fx0, fp0, a1x); a1x = MFMA32(fx1, fp1, a1x);
                    }
                }
                bf16x8 fc[2][4];
#pragma unroll
                for (int j = 0; j < 4; ++j) fc[0][j] = *(const LAS bf16x8*)LDSB(a_cs, j * 1024);
#pragma unroll
                for (int g = 0; g < KS / 4; ++g) {
                    if (g + 1 < KS / 4) {
#pragma unroll
                        for (int j = 0; j < 4; ++j) fc[(g + 1) & 1][j] = *(const LAS bf16x8*)LDSB(a_cs, ((g + 1) * 4 + j) * 1024);
                    }
                    __builtin_amdgcn_sched_barrier(0);
#pragma unroll
                    for (int j = 0; j < 4; ++j) a2 = MFMA32(fc[g & 1][j], qf[g * 4 + j], a2);
                    __builtin_amdgcn_sched_barrier(0);
                }
            }
            if (ML) {
#pragma unroll
                for (int ks = 0; ks < KS; ++ks) { const bf16x8 fcx = *(const LAS bf16x8*)(L + lofs + 49152u + ks * 1024); a2x = MFMA32(fcx, qf[ks], a2x); }
            }
#pragma unroll
            for (int ks = 0; ks < 8; ++ks) kt[ks] = LDG(bf16x8, KTf + tb * 8 * 512, lofs + ks * 1024);
            const int t = tb * 32 + (int)l31x; const float wi = *(const LAS float*)LDSB(a_tv, 2 * 512); float inv = 1.f;
            if (ML) { const float d0v = a1x[0] + wi * a2x[0]; const float dsw = __shfl_xor(d0v, 32); const float den = hhx ? dsw : d0v; inv = frcp(fmaxf(fabsf(den), *(const LAS float*)LDSB(a_tv, 3 * 512))); }
            bf16_t* hp = Hout + ((size_t)seq * S + (size_t)c * 128 + t) * DM + head * 256 + split * 64 + vt * 32 + 4 * (int)hhx;
#pragma unroll
            for (int q = 0; q < 4; ++q) {
                u32x2 o; o.x = pk2((a1[q * 4] + wi * a2[q * 4]) * inv, (a1[q * 4 + 1] + wi * a2[q * 4 + 1]) * inv);
                o.y = pk2((a1[q * 4 + 2] + wi * a2[q * 4 + 2]) * inv, (a1[q * 4 + 3] + wi * a2[q * 4 + 3]) * inv);
                *(u32x2*)(hp + 8 * q) = o;
            }
        }
        BAR_LDS();
        if (!ML && has_next) {
            const bf16_t* VTfn = VTg + blkn * (size_t)(256 * 128) + split * (2 * 8 * 512);
#pragma unroll
            for (int i = 0; i < 2; ++i) vtr[i] = LDG(u32x4, VTfn, tofs + i * 8192);
        }
#pragma unroll
        for (int i = 0; i < 2; ++i) {
            const unsigned pidx = (unsigned)i * 512u + (tofs >> 4);
            const unsigned s0 = ((pidx >> 6) & 7u) * 16u + ((pidx >> 5) & 1u) * 8u;
            const u32x4 vv = *(const LAS u32x4*)LDSB(a_cp, 65536 + i * 8192);
            const f32x4 w0 = *(const LAS f32x4*)(L + 147456u + 4u * 512u + s0 * 4u), w1 = *(const LAS f32x4*)(L + 147456u + 4u * 512u + s0 * 4u + 16u);
            u32x4 o;
            o.x = pk2(bflo(vv.x) * w0[0], bfhi(vv.x) * w0[1]); o.y = pk2(bflo(vv.y) * w0[2], bfhi(vv.y) * w0[3]);
            o.z = pk2(bflo(vv.z) * w1[0], bfhi(vv.z) * w1[1]); o.w = pk2(bflo(vv.w) * w1[2], bfhi(vv.w) * w1[3]);
            *(LAS u32x4*)LDSB(a_cp, 114688 + i * 8192) = o;
        }
        if (ML && tid < 16) {
            const unsigned s0 = (unsigned)(tid >> 1) * 16u + (unsigned)(tid & 1) * 8u;
            const f32x4 w0 = *(const LAS f32x4*)(L + 147456u + 4u * 512u + s0 * 4u), w1 = *(const LAS f32x4*)(L + 147456u + 4u * 512u + s0 * 4u + 16u);
            u32x4 o; o.x = pk2(w0[0], w0[1]); o.y = pk2(w0[2], w0[3]); o.z = pk2(w1[0], w1[1]); o.w = pk2(w1[2], w1[3]);
            *(LAS u32x4*)(L + 40960u + ((unsigned)(tid >> 1) * 64u + 32u * (unsigned)(tid & 1)) * 16u) = o;
        }
        BAR_LDS();
        bf16x8 fv[8];
#pragma unroll
        for (int ks = 0; ks < 8; ++ks) fv[ks] = *(const LAS bf16x8*)LDSB(a_vt, (114688 - 65536) + ks * 1024);
#pragma unroll
        for (int i = 0; i < NST; ++i) {
            bf16x8 ktn[8];
            if (i + 1 < NST) {
#pragma unroll
                for (int ks = 0; ks < 8; ++ks) ktn[ks] = LDG(bf16x8, KTf + (tb + 4 * (i + 1)) * 8 * 512, lofs + ks * 1024);
            }
            if (ML && vt == 0) {
#pragma unroll
                for (int r = 0; r < 16; ++r) stX[r] *= dec;
#pragma unroll
                for (int ks = 0; ks < 8; ++ks) { const bf16x8 fw = *(const LAS bf16x8*)(L + lofs + 40960u + ks * 1024); stX = MFMA32(kt[ks], fw, stX); }
#pragma unroll
                for (int q = 0; q < 4; ++q) {
                    u32x2 o; o.x = pk2(stX[q * 4], stX[q * 4 + 1]); o.y = pk2(stX[q * 4 + 2], stX[q * 4 + 3]);
                    *(LAS u32x2*)(L + 49152u + (unsigned)((tb * 2 + (q >> 1)) * 1024 + (q & 1) * 512) + l31x * 16u + 8u * hhx) = o;
                }
            }
#pragma unroll
            for (int r = 0; r < 16; ++r) stC[i][r] *= dec;
            __builtin_amdgcn_sched_barrier(0);
#pragma unroll
            for (int ks = 0; ks < 8; ++ks) stC[i] = MFMA32(kt[ks], fv[ks], stC[i]);
            __builtin_amdgcn_sched_barrier(0);
#pragma unroll
            for (int q = 0; q < 4; ++q) {
                u32x2 o; o.x = pk2(stC[i][q * 4], stC[i][q * 4 + 1]); o.y = pk2(stC[i][q * 4 + 2], stC[i][q * 4 + 3]);
                *(LAS u32x2*)LDSB(a_csw, (8 * i + (q >> 1)) * 1024 + (q & 1) * 512) = o;
            }
            if (i + 1 < NST) {
#pragma unroll
                for (int ks = 0; ks < 8; ++ks) kt[ks] = ktn[ks];
            }
            if (NST > 1 && i == 0 && has_next) {
                const bf16_t* Qfn = Qg + blkn * (size_t)(128 * DK);
#pragma unroll
                for (int ks = 0; ks < KS; ++ks) qf[ks] = LDG(bf16x8, Qfn + tb * KS * 512, lofs + ks * 1024);
            }
        }
        if (ML && has_next) {
#pragma unroll
            for (int ks = 0; ks < KS; ++ks) qf[ks] = qfn[ks];
        }
        if (ML) m = m_new;
        BAR_LDS();
    }
#undef LDSB
#undef KDMA
#undef LDG
#undef MK_BASES
}

DI void phase_mixer(const Params& p, unsigned char* smem, int layer, int S, int nseq, int tid) {
    const int nch = S / 128, NI = nseq * 32;
    for (int it = blockIdx.x; it < 2 * NI; it += gridDim.x) {
        const int mixer = it / NI, r = it % NI;
        const int head = r & 3, dir = (r >> 2) & 1, split = (r >> 3) & 3, seq = r >> 5;
        if (mixer == 0) mixer_item<256, false>(tid, smem, S, nch, seq, head, dir, split, p.Qb, p.Kb, p.KbT, p.VbT, dir ? p.H3 : p.H2, nullptr, p.lg[layer * 8 + dir * 4 + head]);
        else mixer_item<128, true>(tid, smem, S, nch, seq, head, dir, split, p.Qa, p.Ka, p.KaT, p.VaT, dir ? p.H1 : p.H0, p.gates, 0.f);
    }
}


#define XB_TMO      128
#define XB_XCNT(j)  (256  + 64 * (j))
#define XB_XSUB(j)  (1280 + 64 * (j))
#define XB_XGEN(j)  (2304 + 64 * (j))
#define XB_TOP      3328
#define XB_TOPGEN   3392
#define XCD_BAR_WORDS 3456
#define XB_SPIN_CAP (1u << 22)
DI unsigned xb_ld(unsigned* p)              { return __hip_atomic_load(p, __ATOMIC_RELAXED, __HIP_MEMORY_SCOPE_AGENT); }
DI unsigned xb_add(unsigned* p, unsigned v) { return __hip_atomic_fetch_add(p, v, __ATOMIC_RELAXED, __HIP_MEMORY_SCOPE_AGENT); }
DI unsigned xb_xcc_id() { return (unsigned)__builtin_amdgcn_s_getreg((3 << 11) | 20) & 0xFu; }
#define XB_SPIN(cond, bar) do { unsigned _sp = 0; while (cond) { __builtin_amdgcn_s_sleep(1); \
    if ((++_sp & 255u) == 0u) { if (xb_ld(&(bar)[XB_TMO])) break; if (_sp > XB_SPIN_CAP) { atomicAdd(&(bar)[XB_TMO], 1u); break; } } } } while (0)
struct XcdBarrier { unsigned* bar; unsigned x; volatile LAS unsigned* st; };
DI XcdBarrier xcd_barrier_post(unsigned* bar, volatile LAS unsigned* st, int tid) {
    XcdBarrier b; b.bar = bar; b.x = xb_xcc_id(); b.st = st;
    if (tid == 0) (void)xb_add(&bar[XB_XCNT(b.x)], 1u);
    return b;
}
DI void xcd_barrier_complete(unsigned* bar, unsigned x, unsigned& nloc, unsigned& nx) {
    const unsigned G = gridDim.x * gridDim.y * gridDim.z;
    unsigned sum, cnt, mine, sp = 0u;
    for (;;) {
        sum = 0u; cnt = 0u; mine = 0u;
#pragma unroll
        for (unsigned j = 0; j < 16; ++j) { const unsigned c = xb_ld(&bar[XB_XCNT(j)]); sum += c; cnt += (c > 0u) ? 1u : 0u; mine = (j == x) ? c : mine; }
        if (sum == G) break;
        __builtin_amdgcn_s_sleep(1);
        if ((++sp & 255u) == 0u) { if (xb_ld(&bar[XB_TMO])) break; if (sp > XB_SPIN_CAP) { atomicAdd(&bar[XB_TMO], 1u); break; } }
    }
    nloc = mine > 0u ? mine : 1u; nx = cnt > 0u ? cnt : 1u;
}
DI void xcd_barrier(const XcdBarrier& b, int tid) {
    asm volatile("s_waitcnt vmcnt(0)" ::: "memory");
    __syncthreads();
    if (tid == 0) {
        unsigned* bar = b.bar;
        __builtin_amdgcn_s_waitcnt(0);
        unsigned nloc = b.st[0], nx = b.st[1];
        if (nloc == 0u) { xcd_barrier_complete(bar, b.x, nloc, nx); b.st[0] = nloc; b.st[1] = nx; }
        const unsigned old = xb_add(&bar[XB_XSUB(b.x)], 1u);
        const unsigned gen = old / nloc;
        if (old + 1u == (gen + 1u) * nloc) {
            __builtin_amdgcn_fence(__ATOMIC_RELEASE, "agent");
            asm volatile("s_waitcnt vmcnt(0)" ::: "memory");
            const unsigned og = xb_add(&bar[XB_TOP], 1u);
            const unsigned tg = og / nx;
            if (og + 1u == (tg + 1u) * nx) xb_add(&bar[XB_TOPGEN], 1u);
            else XB_SPIN(xb_ld(&bar[XB_TOPGEN]) == tg, bar);
            __builtin_amdgcn_fence(__ATOMIC_ACQUIRE, "agent");
            xb_add(&bar[XB_XGEN(b.x)], 1u);
            asm volatile("s_waitcnt vmcnt(0)" ::: "memory");
        } else {
            XB_SPIN(xb_ld(&bar[XB_XGEN(b.x)]) == gen, bar);
            __builtin_amdgcn_fence(__ATOMIC_ACQUIRE, "agent");
            asm volatile("s_waitcnt vmcnt(0)" ::: "memory");
        }
    }
    __syncthreads();
}

DI size_t al256(size_t x) { return (x + 255) & ~(size_t)255; }
DI void build_params(Params& p, const KArgs& a, char* w, int G) {
    p.x_prompt = a.in[0]; p.x_sample = a.in[1]; p.ln_in_g = a.in[2]; p.ln_in_b = a.in[3]; p.w_in = a.in[4]; p.b_if = a.in[5]; p.lg = a.in[6]; p.g_a = a.in[7]; p.g_b = a.in[8];
    p.w_o = a.in[9]; p.ln1_g = a.in[10]; p.ln1_b = a.in[11]; p.w_up = a.in[12]; p.conv_w = a.in[13]; p.conv_b = a.in[14]; p.w_down = a.in[15]; p.ln2_g = a.in[16]; p.ln2_b = a.in[17];
    p.out = a.out; p.G = G; p.pad = 0;
    size_t o = 0;
    p.WinT = (bf16_t*)(w + o); o += al256((size_t)2 * NW * DM * 2);
    p.WoT = (bf16_t*)(w + o); o += al256((size_t)2 * DM * DM * 2);
    p.WupT = (bf16_t*)(w + o); o += al256((size_t)2 * NUP * DM * 2);
    p.WdT = (bf16_t*)(w + o); o += al256((size_t)2 * DM * DFF * 2);
    p.cosT = (float*)(w + o); o += (size_t)4096 * 128 * 4; p.sinT = (float*)(w + o); o += (size_t)4096 * 128 * 4;
    p.cosTT = (float*)(w + o); o += (size_t)4096 * 128 * 4; p.sinTT = (float*)(w + o); o += (size_t)4096 * 128 * 4;
    p.gates = (float*)(w + o); o += (size_t)G * 96;
    p.gpre = (float*)(w + o); o += (size_t)G * 64;
    p.WgT = (bf16_t*)(w + o); o += 65536;
    char* ubase = w + o;
    const size_t g1 = (size_t)G * 1024;
    p.Qb = (bf16_t*)(w + o); o += 2 * g1; p.Kb = (bf16_t*)(w + o); o += 2 * g1;
    p.Qa = (bf16_t*)(w + o); o += g1; p.Ka = (bf16_t*)(w + o); o += g1;
    p.E = (bf16_t*)(w + o); o += 8 * g1;
    p.KbT = (bf16_t*)(w + o); o += 2 * g1; p.KaT = (bf16_t*)(w + o); o += g1;
    p.VaT = (bf16_t*)(w + o); o += 2 * g1; p.VbT = (bf16_t*)(w + o); o += 2 * g1;
    p.H0 = (bf16_t*)(w + o); o += 2 * g1; p.H1 = (bf16_t*)(w + o); o += 2 * g1;
    p.H2 = (bf16_t*)(w + o); o += 2 * g1; p.H3 = (bf16_t*)(w + o); o += 2 * g1;
    p.xb = p.H0; p.merged = (bf16_t*)ubase; p.hu = (bf16_t*)ubase; p.ff = (bf16_t*)(ubase + (size_t)G * NUP * 2);
}
DI void run_phase(const Params& p, unsigned char* smem, int ph, const int tid) {
    const int G = p.G;
    const int g = (ph - 1) / 19, q = (ph - 1) % 19;
    const int T0 = g * G;
    const int S = T0 < TPROMPT ? 2048 : 4096;
    const int nseq = G / S;
    float* xg = p.out + (size_t)T0 * DM;
    bf16_t* xin = (bf16_t*)xg;
    bf16_t* yb = p.H2;
    LAS unsigned char* lds = (LAS unsigned char*)smem;
    if (q == 0) return;
    const int l = (q - 1) / 9, k = (q - 1) % 9;
    pg8::StaticOrder so;
    switch (k) {
    case 0: {
        { pg8::Gemm gm{xin, p.WinT + (size_t)l * NW * DM, G, NNORM, DM}; so.init(gm.M, gm.N, (int)gridDim.x, (int)blockIdx.x); EpiInN e{&p, S, smem}; pg8::gemm_phase(lds, gm, so, e, tid); }
        { pg8::Gemm gm{p.WinT + ((size_t)l * NW + NNORM) * DM, xin, NTR, G, DM}; so.init(gm.M, gm.N, (int)gridDim.x, (int)blockIdx.x); EpiInT e{&p, S}; pg8::gemm_phase(lds, gm, so, e, tid); }
        phase_gates2(p, smem, l, xin, G / 128, tid);
    } break;
    case 1: phase_mixer(p, smem, l, S, nseq, tid); break;
    case 2: phase_merge(p, l, G, tid); break;
    case 3: { pg8::Gemm gm{p.merged, p.WoT + (size_t)l * DM * DM, G, DM, DM}; so.init(gm.M, gm.N, (int)gridDim.x, (int)blockIdx.x); EpiB16 e{yb, DM}; pg8::gemm_phase(lds, gm, so, e, tid); } break;
    case 4: phase_ln(yb, 2, xin, p.ln1_g + l * DM, p.ln1_b + l * DM, nullptr, p.xb, G, tid, smem, nullptr, nullptr, nullptr); break;
    case 5: { pg8::Gemm gm{p.xb, p.WupT + (size_t)l * NUP * DM, G, NUP, DM}; so.init(gm.M, gm.N, (int)gridDim.x, (int)blockIdx.x); EpiB16 e{p.hu, NUP}; pg8::gemm_phase(lds, gm, so, e, tid); } break;
    case 6: phase_conv(p, l, G, S, tid); break;
    case 7: { pg8::Gemm gm{p.ff, p.WdT + (size_t)l * DM * DFF, G, DM, DFF}; so.init(gm.M, gm.N, (int)gridDim.x, (int)blockIdx.x); EpiB16 e{yb, DM}; pg8::gemm_phase(lds, gm, so, e, tid); } break;
    default: {
        const int T1 = T0 + G;
        const int nrep = (l == 1 && T1 < TTOT) ? 2 : 1;
        _Pragma("nounroll") for (int rep = 0; rep < nrep; ++rep) {
            const void* src; const float* gg; const float* bb; float* df; bf16_t* db;
            if (rep == 0) { src = yb; gg = p.ln2_g + l * DM; bb = p.ln2_b + l * DM; df = l == 1 ? xg : nullptr; db = l == 1 ? nullptr : xin; }
            else { src = T1 < TPROMPT ? p.x_prompt + (size_t)T1 * DM : p.x_sample + (size_t)(T1 - TPROMPT) * DM; gg = p.ln_in_g; bb = p.ln_in_b; df = nullptr; db = (bf16_t*)(p.out + (size_t)T1 * DM); }
            phase_ln(src, rep == 0 ? 2 : 0, p.xb, gg, bb, df, db, G, tid, smem, nullptr, nullptr, nullptr);
        }
    } break;
    }
}

__global__ __launch_bounds__(512, 2) void mega(KArgs a, int ph_lo, int ph_hi) {
    extern __shared__ __attribute__((aligned(16))) unsigned char smem[];
    const int wid0 = __builtin_amdgcn_readfirstlane((int)threadIdx.x >> 6);
#define MK_TID() (wid0 * 64 + (int)__builtin_amdgcn_mbcnt_hi(~0u, __builtin_amdgcn_mbcnt_lo(~0u, 0u)))
    const bool multi = ph_hi - ph_lo > 1;
    XcdBarrier xb; xb.bar = a.bar; xb.x = 0; xb.st = (volatile LAS unsigned*)((LAS unsigned char*)smem + 151552);
    if (multi) {
        int tid1 = MK_TID(); asm volatile("" : "+v"(tid1));
        if (tid1 == 0) { xb.st[0] = 0u; xb.st[1] = 0u; }
        __syncthreads();
        xb = xcd_barrier_post(a.bar, xb.st, tid1);
    }
    if (ph_hi < -1000) cg::this_grid().sync();
    if (ph_lo == 0) {
        int tid0 = MK_TID(); asm volatile("" : "+v"(tid0));
        Params p; build_params(p, a, a.ws, a.G);
        phase_prep(p, tid0);
        phase_ln(p.x_prompt, 0, nullptr, p.ln_in_g, p.ln_in_b, nullptr, (bf16_t*)p.out, a.G, tid0, smem, nullptr, nullptr, nullptr);
        ph_lo = 1;
        if (ph_lo < ph_hi) xcd_barrier(xb, tid0);
    }
    for (int ph = ph_lo; ph < ph_hi; ++ph) {
        int wq = wid0; asm volatile("" : "+s"(wq));
        int tid = wq * 64 + (int)__builtin_amdgcn_mbcnt_hi(~0u, __builtin_amdgcn_mbcnt_lo(~0u, 0u)); asm volatile("" : "+v"(tid));
        int G = a.G; char* w = a.ws; asm volatile("" : "+s"(G));
        Params p; build_params(p, a, w, G);
        if ((ph - 1) % 19 == 0) continue;
        run_phase(p, smem, ph, tid);
        if (ph + 1 < ph_hi) xcd_barrier(xb, tid);
    }
}

#ifndef ONE_LAUNCH
#define ONE_LAUNCH 1
#endif

extern "C" void kernel_launch(void* const* d_in, const int* in_sizes, int n_in, void* d_out, int out_size, void* d_ws, size_t ws_size, hipStream_t stream) {
    static int grid = 0;
    if (grid == 0) {
        int dev = 0, cus = 0, per_cu = 0;
        hipGetDevice(&dev);
        hipDeviceGetAttribute(&cus, hipDeviceAttributeMultiprocessorCount, dev);
        hipFuncSetAttribute((const void*)mega, hipFuncAttributeMaxDynamicSharedMemorySize, LDS_BYTES);
        hipOccupancyMaxActiveBlocksPerMultiprocessor(&per_cu, (const void*)mega, 512, LDS_BYTES);
        (void)hipGetLastError();
        if (per_cu < 1) per_cu = 1;
        if (cus <= 0) cus = 256;
        grid = cus;
    }
    KArgs p{};
    for (int i = 0; i < 18; ++i) p.in[i] = (const float*)d_in[i];
    p.out = (float*)d_out; p.ws = (char*)d_ws + 16384; p.bar = (unsigned*)d_ws;
    auto need = [](size_t G) { return (size_t)2 * NW * DM * 2 + (size_t)2 * DM * DM * 2 + (size_t)2 * NUP * DM * 2 + (size_t)2 * DM * DFF * 2 + (size_t)4 * 4096 * 128 * 4 + G * 160 + G * (size_t)(NW) * 2 + G * (size_t)4 * DM * 2 + 4096 + 16384 + 65536; };
    int G = 32768;
    if (need(G) > ws_size) G = 16384;
    p.G = G;
    const int ngroups = TTOT / G;
    const int nph = 1 + ngroups * 19;
#if ONE_LAUNCH
    hipMemsetAsync(d_ws, 0, 16384, stream);
    int lo = 0, hi = nph;
    void* args[] = {&p, &lo, &hi};
    hipError_t e = hipLaunchCooperativeKernel((const void*)mega, dim3(grid), dim3(512), args, LDS_BYTES, stream);
    if (e != hipSuccess) fprintf(stderr, "cooperative launch failed: %s (grid %d)\n", hipGetErrorString(e), grid);
#else
    for (int ph = 0; ph < nph; ++ph) hipLaunchKernelGGL(mega, dim3(grid), dim3(512), LDS_BYTES, stream, p, ph, ph + 1);
#endif
}
```

```cpp
#include <hip/hip_runtime.h>
#include <hip/hip_cooperative_groups.h>
#include <cstdio>
namespace cg = cooperative_groups;

#define LAS __attribute__((address_space(3)))
#define DI __device__ __forceinline__
typedef unsigned short bf16_t;
typedef short bf16x8 __attribute__((ext_vector_type(8)));
typedef float f32x4 __attribute__((ext_vector_type(4)));
typedef float f32x16 __attribute__((ext_vector_type(16)));
typedef unsigned u32x4 __attribute__((ext_vector_type(4)));
typedef unsigned u32x2 __attribute__((ext_vector_type(2)));

constexpr int DM = 1024, NIN = 9232, DFF = 2816, NUP = 5632;
constexpr int NNORM = 7168, NTR = 2048, NW = NNORM + NTR;
constexpr int TTOT = 98304, TPROMPT = 65536;
constexpr int LDS_BYTES = 151552 + 16;
constexpr float ALPHA = 1.41421356237f;
constexpr float LN_EPS = 1e-5f;

struct KArgs {
    const float* in[18];
    float* out; char* ws; unsigned* bar;
    int G; int pad;
};
struct Params {
    const float* x_prompt; const float* x_sample; const float* ln_in_g; const float* ln_in_b; const float* w_in; const float* b_if;
    const float* lg; const float* g_a; const float* g_b; const float* w_o; const float* ln1_g; const float* ln1_b; const float* w_up;
    const float* conv_w; const float* conv_b; const float* w_down; const float* ln2_g; const float* ln2_b;
    float* out;
    bf16_t* WinT; bf16_t* WoT; bf16_t* WupT; bf16_t* WdT;
    float* cosT; float* sinT; float* cosTT; float* sinTT;
    float* gates; float* gpre; bf16_t* WgT;
    bf16_t* Qb; bf16_t* Kb; bf16_t* Qa; bf16_t* Ka; bf16_t* E; bf16_t* KbT; bf16_t* KaT; bf16_t* VaT; bf16_t* VbT;
    bf16_t* H0; bf16_t* H1; bf16_t* H2; bf16_t* H3;
    bf16_t* xb; bf16_t* merged; bf16_t* hu; bf16_t* ff;
    int G; int pad;
};

typedef float f32x2 __attribute__((ext_vector_type(2)));
typedef __bf16 bf16v2 __attribute__((ext_vector_type(2)));
DI unsigned f2bf(float x) { unsigned u = __float_as_uint(x); u += 0x7fffu + ((u >> 16) & 1u); return u >> 16; }
DI unsigned pk2(float lo, float hi) { const f32x2 v = {lo, hi}; return __builtin_bit_cast(unsigned, __builtin_convertvector(v, bf16v2)); }
DI float bflo(unsigned w) { return __uint_as_float(w << 16); }
DI float bfhi(unsigned w) { return __uint_as_float(w & 0xffff0000u); }
DI float frcp(float x) { return __builtin_amdgcn_rcpf(x); }
DI float sigmoidf_(float x) { return frcp(1.f + __expf(-x)); }
#define MFMA32(a, b, c) __builtin_amdgcn_mfma_f32_32x32x16_bf16((a), (b), (c), 0, 0, 0)

namespace pg8 {
constexpr int BM = 256, BK = 64, HALF = 128, HTB = HALF * BK * 2, STAGE_BYTES = 8 * HTB, NXCD = 8, WGM = 8;
DI int lds_byte(int r, int c) { const int st = (r >> 4) * 2 + (c >> 5), rr = r & 15, cc = c & 31, ob = rr * 64 + cc * 2; return st * 1024 + (ob ^ (((ob >> 9) & 1) << 5)); }
DI void stage_rc(int b, int& R, int& C) { const int st = b / 1024, sb = b % 1024, swz = sb ^ (((sb >> 9) & 1) << 5); R = (st >> 1) * 16 + swz / 64; C = (st & 1) * 32 + (swz % 64) / 2; }
DI int perm32(int rho) { const int n = rho >> 4, i = rho & 15; return 8 * (i >> 2) + 4 * n + (i & 3); }
struct Unit { int pm, pn; };
struct Gemm { const bf16_t* A; const bf16_t* Bt; int M, N, K; };
struct StaticOrder {
    int nM, nN, nwg, G, c;
    DI void init(int M, int N, int G_, int c_) { nM = M / BM; nN = N / BM; nwg = nM * nN; G = G_; c = c_; }
    DI bool next(int i, Unit& u) const {
        const long L = (long)i * G + c; if (L >= nwg) return false;
        int wgid = (int)L; { const int q = nwg / NXCD, r = nwg % NXCD, xcd = wgid % NXCD, off = wgid / NXCD; wgid = (xcd < r ? xcd * (q + 1) : r * (q + 1) + (xcd - r) * q) + off; }
        const int nig = WGM * nN, gid = wgid / nig, fm = gid * WGM, gsz = (nM - fm) < WGM ? (nM - fm) : WGM;
        u.pm = fm + ((wgid % nig) % gsz); u.pn = (wgid % nig) / gsz; return true;
    }
};

template <class Epi>
DI void gemm_phase(LAS unsigned char* lds, const Gemm g, const StaticOrder& S, const Epi& E, const int tid) {
    const int wid = __builtin_amdgcn_readfirstlane(tid >> 6), lane = tid & 63, wr = wid >> 2, wc = wid & 3, fr = lane & 15, fq = lane >> 4;
    const int K = g.K, nt = K / BK;
    unsigned voffA[2], voffB[2];
#pragma unroll
    for (int i = 0; i < 2; ++i) { int R, C; stage_rc(tid * 16 + i * 8192, R, C); const int Rb = Epi::PERM ? ((R & ~31) + perm32(R & 31)) : R;
        voffA[i] = (unsigned)(R * K + C) * 2u; voffB[i] = (unsigned)(Rb * K + C) * 2u; }
    const size_t kstep = (size_t)(BK * 2);
    const size_t hstep = (size_t)HALF * K * 2;
    const size_t tstep = 2 * hstep;
    const unsigned ldsw = (unsigned)wid * 1024u;
    const int aoff = lds_byte(wr * 64 + fr, fq * 8), boff = lds_byte(wc * 32 + fr, fq * 8);
#define PG8_SA(b, h) (((b) * 2 + (h)) * HTB)
#define PG8_SB(b, h) ((4 + (b) * 2 + (h)) * HTB)
#define PG8_STAGE(bufoff, gbase, voff) do { _Pragma("unroll") for (int _i = 0; _i < 2; ++_i) \
        __builtin_amdgcn_global_load_lds((const unsigned*)((const char*)(gbase) + (voff)[_i]), (LAS unsigned*)(lds + (bufoff) + ldsw + _i * 8192), 16, 0, 0); } while (0)
#define PG8_LDA(dst, b, h) do { _Pragma("unroll") for (int m = 0; m < 4; ++m) _Pragma("unroll") for (int k = 0; k < 2; ++k) dst[m][k] = *(const LAS bf16x8*)(lds + PG8_SA(b, h) + aoff + m * 2048 + k * 1024); } while (0)
#define PG8_LDB(dst, b, h) do { _Pragma("unroll") for (int n = 0; n < 2; ++n) _Pragma("unroll") for (int k = 0; k < 2; ++k) dst[n][k] = *(const LAS bf16x8*)(lds + PG8_SB(b, h) + boff + n * 2048 + k * 1024); } while (0)
#define PG8_MMA(ai, bj, At, Bt) do { __builtin_amdgcn_s_setprio(1); _Pragma("unroll") for (int m = 0; m < 4; ++m) _Pragma("unroll") for (int n = 0; n < 2; ++n) _Pragma("unroll") for (int k = 0; k < 2; ++k) \
        acc[ai][bj][m][n] = __builtin_amdgcn_mfma_f32_16x16x32_bf16(Bt[n][k], At[m][k], acc[ai][bj][m][n], 0, 0, 0); __builtin_amdgcn_s_setprio(0); } while (0)
#define PG8_WAIT_V(n) asm volatile("s_waitcnt vmcnt(" #n ")" ::: "memory")
#define PG8_WAIT_L(n) asm volatile("s_waitcnt lgkmcnt(" #n ")" ::: "memory")
#define PG8_BAR __builtin_amdgcn_s_barrier()
#define PG8_SCHED __builtin_amdgcn_sched_barrier(0)
    Unit cur, nxt; int ui = 0;
    if (!S.next(0, cur)) return;
    f32x4 acc[2][2][4][2];
#pragma unroll
    for (int a = 0; a < 2; ++a)
#pragma unroll
        for (int b = 0; b < 2; ++b)
#pragma unroll
            for (int m = 0; m < 4; ++m)
#pragma unroll
                for (int n = 0; n < 2; ++n) acc[a][b][m][n] = (f32x4){0.f, 0.f, 0.f, 0.f};
    bf16x8 At[4][2], B0[2][2], B1[2][2];
    const char* cA = (const char*)g.A + (size_t)cur.pm * tstep; const char* cB = (const char*)g.Bt + (size_t)cur.pn * tstep;
    PG8_STAGE(PG8_SB(0, 0), cB, voffB); PG8_STAGE(PG8_SA(0, 0), cA, voffA); PG8_STAGE(PG8_SB(0, 1), cB + hstep, voffB); PG8_STAGE(PG8_SA(0, 1), cA + hstep, voffA);
    if (wr == 1) PG8_BAR;
    PG8_WAIT_V(4); PG8_BAR;
    PG8_STAGE(PG8_SB(1, 0), cB + kstep, voffB); PG8_STAGE(PG8_SA(1, 0), cA + kstep, voffA); PG8_STAGE(PG8_SB(1, 1), cB + hstep + kstep, voffB);
    PG8_WAIT_V(6); PG8_BAR;
    for (;;) {
        const bool has_next = S.next(ui + 1, nxt);
        const char* nA = has_next ? (const char*)g.A + (size_t)nxt.pm * tstep : cA; const char* nB = has_next ? (const char*)g.Bt + (size_t)nxt.pn * tstep : cB;
        for (int t = 0; t < nt; t += 2) {
            const bool last = (t == nt - 2);
            const char* a1 = cA + (size_t)(t + 1) * kstep;
            const char* a2 = last ? nA : cA + (size_t)(t + 2) * kstep; const char* b2 = last ? nB : cB + (size_t)(t + 2) * kstep;
            const char* a3 = a2 + kstep; const char* b3 = b2 + kstep;
            PG8_LDB(B0, 0, 0); PG8_SCHED; PG8_LDA(At, 0, 0); PG8_STAGE(PG8_SA(1, 1), a1 + hstep, voffA);
            PG8_WAIT_L(8); PG8_BAR; PG8_WAIT_L(0); PG8_MMA(0, 0, At, B0); PG8_BAR; PG8_SCHED;
            PG8_LDB(B1, 0, 1); PG8_STAGE(PG8_SB(0, 0), b2, voffB);
            PG8_BAR; PG8_WAIT_L(0); PG8_MMA(0, 1, At, B1); PG8_BAR;
            PG8_LDA(At, 0, 1); PG8_STAGE(PG8_SA(0, 0), a2, voffA);
            PG8_BAR; PG8_WAIT_L(0); PG8_MMA(1, 0, At, B0); PG8_BAR; PG8_SCHED;
            PG8_STAGE(PG8_SB(0, 1), b2 + hstep, voffB);
            PG8_WAIT_V(6); PG8_BAR; PG8_MMA(1, 1, At, B1); PG8_BAR;
            PG8_LDB(B0, 1, 0); PG8_SCHED; PG8_LDA(At, 1, 0); PG8_STAGE(PG8_SA(0, 1), a2 + hstep, voffA);
            PG8_WAIT_L(8); PG8_BAR; PG8_WAIT_L(0); PG8_MMA(0, 0, At, B0); PG8_BAR; PG8_SCHED;
            PG8_LDB(B1, 1, 1); PG8_STAGE(PG8_SB(1, 0), b3, voffB);
            PG8_BAR; PG8_WAIT_L(0); PG8_MMA(0, 1, At, B1); PG8_BAR;
            PG8_LDA(At, 1, 1); PG8_STAGE(PG8_SA(1, 0), a3, voffA);
            PG8_BAR; PG8_WAIT_L(0); PG8_MMA(1, 0, At, B0); PG8_BAR; PG8_SCHED;
            PG8_STAGE(PG8_SB(1, 1), b3 + hstep, voffB);
            PG8_WAIT_V(6); PG8_BAR; PG8_MMA(1, 1, At, B1); PG8_BAR;
        }
        { int fr2 = fr, fq2 = fq; asm volatile("" : "+v"(fr2), "+v"(fq2)); E(acc, cur, wr, wc, fr2, fq2); }
        if (!has_next) break;
#pragma unroll
        for (int a = 0; a < 2; ++a)
#pragma unroll
            for (int b = 0; b < 2; ++b)
#pragma unroll
                for (int m = 0; m < 4; ++m)
#pragma unroll
                    for (int n = 0; n < 2; ++n) acc[a][b][m][n] = (f32x4){0.f, 0.f, 0.f, 0.f};
        cur = nxt; cA = nA; cB = nB; ++ui;
    }
    PG8_WAIT_V(0);
    if (wr == 0) PG8_BAR;
    PG8_BAR;
#undef PG8_SA
#undef PG8_SB
#undef PG8_STAGE
#undef PG8_LDA
#undef PG8_LDB
#undef PG8_MMA
#undef PG8_WAIT_V
#undef PG8_WAIT_L
#undef PG8_BAR
#undef PG8_SCHED
}
}

typedef f32x4 AccT[2][2][4][2];
DI u32x4 pack8(f32x4 a, f32x4 b) { u32x4 w; w.x = pk2(a[0], a[1]); w.y = pk2(a[2], a[3]); w.z = pk2(b[0], b[1]); w.w = pk2(b[2], b[3]); return w; }
DI size_t fragoff(int row, int kidx, int KS) { return (size_t)((((row >> 5) * KS + (kidx >> 4)) * 64 + (row & 31) + 32 * ((kidx >> 3) & 1)) * 8); }

DI void kt_store(unsigned char* sc, const u32x4 w, int fr, int fq, bf16_t* ktbase, int dbase, int sbase) {
    unsigned short* s16 = (unsigned short*)sc;
#pragma unroll
    for (int j = 0; j < 8; ++j) s16[(8 * fq + j) * 24 + fr] = (unsigned short)((w[j >> 1] >> (16 * (j & 1))) & 0xffffu);
    asm volatile("s_waitcnt lgkmcnt(0)" ::: "memory");
    const int L = fr + 16 * fq, fl = L >> 1, th = L & 1;
    const u32x4 r = *(const u32x4*)(sc + (fl * 24 + th * 8) * 2);
    asm volatile("s_waitcnt lgkmcnt(0)" ::: "memory");
    *(u32x4*)(ktbase + fragoff(dbase + fl, sbase + th * 8, 8)) = r;
}
struct EpiInN {
    static constexpr bool PERM = true;
    const Params* p; int S; unsigned char* smem;
    DI void operator()(const AccT& acc, const pg8::Unit& u, int wr, int wc, int fr, int fq) const {
        const int pn = u.pn;
        const int d0 = wc * 32 + 8 * fq;
        if (pn < 8) {
            bf16_t* dst = pn < 4 ? p->Qb : p->Kb; const int head = pn & 3;
#pragma unroll
            for (int ai = 0; ai < 2; ++ai)
#pragma unroll
                for (int m = 0; m < 4; ++m) {
                    const int row = u.pm * 256 + ai * 128 + wr * 64 + m * 16 + fr; const int pos = row % S; const int chunk = row >> 7, t = row & 127;
                    const f32x4 c0 = *(const f32x4*)(p->cosT + pos * 128 + d0), c1 = *(const f32x4*)(p->cosT + pos * 128 + d0 + 4);
                    const f32x4 s0 = *(const f32x4*)(p->sinT + pos * 128 + d0), s1 = *(const f32x4*)(p->sinT + pos * 128 + d0 + 4);
                    const f32x4 x10 = acc[ai][0][m][0], x11 = acc[ai][0][m][1], x20 = acc[ai][1][m][0], x21 = acc[ai][1][m][1];
                    const f32x4 o10 = x10 * c0 - x20 * s0, o11 = x11 * c1 - x21 * s1, o20 = x10 * s0 + x20 * c0, o21 = x11 * s1 + x21 * c1;
                    bf16_t* base = dst + (size_t)(chunk * 4 + head) * (128 * 256);
                    const u32x4 w1 = pack8(o10, o11), w2 = pack8(o20, o21);
                    *(u32x4*)(base + fragoff(t, d0, 16)) = w1;
                    *(u32x4*)(base + fragoff(t, d0 + 128, 16)) = w2;
                    if (pn >= 4) {
                        unsigned char* sc = smem + 131072 + (wr * 4 + wc) * 2048;
                        bf16_t* ktb = p->KbT + (size_t)(chunk * 4 + head) * (256 * 128);
                        kt_store(sc, w1, fr, fq, ktb, wc * 32, wr * 64 + m * 16);
                        kt_store(sc, w2, fr, fq, ktb, 128 + wc * 32, wr * 64 + m * 16);
                    }
                }
        } else if (pn < 12) {
            bf16_t* dst = pn < 10 ? p->Qa : p->Ka;
#pragma unroll
            for (int ai = 0; ai < 2; ++ai)
#pragma unroll
                for (int m = 0; m < 4; ++m) {
                    const int row = u.pm * 256 + ai * 128 + wr * 64 + m * 16 + fr; const int chunk = row >> 7, t = row & 127;
#pragma unroll
                    for (int bj = 0; bj < 2; ++bj) {
                        const int head = ((pn - 8) & 1) * 2 + bj;
                        bf16_t* base = dst + (size_t)(chunk * 4 + head) * (128 * 128);
                        const u32x4 w1 = pack8(acc[ai][bj][m][0], acc[ai][bj][m][1]);
                        *(u32x4*)(base + fragoff(t, d0, 8)) = w1;
                        if (pn >= 10) kt_store(smem + 131072 + (wr * 4 + wc) * 2048, w1, fr, fq, p->KaT + (size_t)(chunk * 4 + head) * (128 * 128), wc * 32, wr * 64 + m * 16);
                    }
                }
        } else {
#pragma unroll
            for (int ai = 0; ai < 2; ++ai)
#pragma unroll
                for (int m = 0; m < 4; ++m) {
                    const int row = u.pm * 256 + ai * 128 + wr * 64 + m * 16 + fr;
                    bf16_t* rp = p->E + (size_t)row * 4096 + (pn - 12) * 256 + d0;
#pragma unroll
                    for (int bj = 0; bj < 2; ++bj) *(u32x4*)(rp + bj * 128) = pack8(acc[ai][bj][m][0], acc[ai][bj][m][1]);
                }
        }
    }
};
struct EpiInT {
    static constexpr bool PERM = true;
    const Params* p; int S;
    DI void operator()(const AccT& acc, const pg8::Unit& u, int wr, int wc, int fr, int fq) const {
        const int pm = u.pm;
        const int s0 = wc * 32 + 8 * fq;
        bf16_t* dst = pm < 4 ? p->VaT : p->VbT; const int head = pm & 3;
#pragma unroll
        for (int ai = 0; ai < 2; ++ai)
#pragma unroll
            for (int bj = 0; bj < 2; ++bj) {
                const int chunk = u.pn * 2 + bj;
                bf16_t* base = dst + (size_t)(chunk * 4 + head) * (256 * 128);
#pragma unroll
                for (int m = 0; m < 4; ++m) { const int v = ai * 128 + wr * 64 + m * 16 + fr; *(u32x4*)(base + fragoff(v, s0, 8)) = pack8(acc[ai][bj][m][0], acc[ai][bj][m][1]); }
            }
    }
};
template <bool XB> struct EpiRes {
    static constexpr bool PERM = false;
    float* Y;
    const bf16_t* X;
    DI void operator()(const AccT& acc, const pg8::Unit& u, int wr, int wc, int fr, int fq) const {
        const int row0 = u.pm * 256 + wr * 64 + fr, col0 = u.pn * 256 + wc * 32 + 4 * fq;
#pragma unroll
        for (int ai = 0; ai < 2; ++ai) {
            f32x4 xv[4][2][2];
#pragma unroll
            for (int m = 0; m < 4; ++m)
#pragma unroll
                for (int bj = 0; bj < 2; ++bj)
#pragma unroll
                    for (int n = 0; n < 2; ++n) {
                        const size_t off = (size_t)(row0 + ai * 128 + m * 16) * DM + col0 + bj * 128 + n * 16;
                        if (XB) { const u32x2 xw = *(const u32x2*)(X + off); xv[m][bj][n] = (f32x4){bflo(xw.x), bfhi(xw.x), bflo(xw.y), bfhi(xw.y)}; }
                        else xv[m][bj][n] = *(const f32x4*)(Y + off);
                    }
#pragma unroll
            for (int m = 0; m < 4; ++m)
#pragma unroll
                for (int bj = 0; bj < 2; ++bj)
#pragma unroll
                    for (int n = 0; n < 2; ++n) {
                        const size_t off = (size_t)(row0 + ai * 128 + m * 16) * DM + col0 + bj * 128 + n * 16;
                        *(f32x4*)(Y + off) = xv[m][bj][n] * ALPHA + acc[ai][bj][m][n];
                    }
        }
    }
};
struct EpiB16 {
    static constexpr bool PERM = true;
    bf16_t* O; int ldc;
    DI void operator()(const AccT& acc, const pg8::Unit& u, int wr, int wc, int fr, int fq) const {
        const int row0 = u.pm * 256 + wr * 64 + fr, col0 = u.pn * 256 + wc * 32 + 8 * fq;
#pragma unroll
        for (int ai = 0; ai < 2; ++ai)
#pragma unroll
            for (int m = 0; m < 4; ++m) { bf16_t* rp = O + (size_t)(row0 + ai * 128 + m * 16) * ldc + col0;
#pragma unroll
                for (int bj = 0; bj < 2; ++bj) *(u32x4*)(rp + bj * 128) = pack8(acc[ai][bj][m][0], acc[ai][bj][m][1]); }
    }
};

DI void transpose_cvt(const float* W, bf16_t* WT, int K, int N, int tid) {
    const long total = (long)N * (K / 8);
    for (long i = (long)blockIdx.x * 512 + tid; i < total; i += (long)gridDim.x * 512) {
        const int n = (int)(i % N), kc = (int)(i / N);
        const float* w = W + (size_t)(kc * 8) * N + n;
        float v[8];
#pragma unroll
        for (int j = 0; j < 8; ++j) v[j] = w[(size_t)j * N];
        u32x4 o; o.x = pk2(v[0], v[1]); o.y = pk2(v[2], v[3]); o.z = pk2(v[4], v[5]); o.w = pk2(v[6], v[7]);
        *(u32x4*)(WT + (size_t)n * K + kc * 8) = o;
    }
}
DI void phase_prep(const Params& p, int tid) {
    const long gtid = (long)blockIdx.x * 512 + tid, gsz = (long)gridDim.x * 512;
    for (long i = gtid; i < 2L * NW * 128; i += gsz) {
        const int n = (int)(i % NW), kc = (int)((i / NW) % 128), l = (int)(i / ((long)NW * 128));
        int src; float sc = 1.f;
        if (n < NNORM) {
            if (n < 1024) src = 3088 + n;
            else if (n < 2048) { src = 4112 + (n - 1024); sc = 0.0625f; }
            else if (n < 2560) { src = n - 2048; sc = 0.08838834764831845f; }
            else if (n < 3072) src = 512 + (n - 2560);
            else if (n < 4096) src = 2048 + (n - 3072);
            else if (n < 5120) src = 6160 + (n - 4096);
            else if (n < 6144) src = 7184 + (n - 5120);
            else src = 8208 + (n - 6144);
        } else {
            const int m = n - NNORM;
            if (m < 1024) src = 1024 + m;
            else src = 5136 + (m - 1024);
        }
        const float* w = p.w_in + (size_t)l * DM * NIN + (size_t)(kc * 8) * NIN + src;
        float v[8];
#pragma unroll
        for (int j = 0; j < 8; ++j) v[j] = w[(size_t)j * NIN] * sc;
        u32x4 o; o.x = pk2(v[0], v[1]); o.y = pk2(v[2], v[3]); o.z = pk2(v[4], v[5]); o.w = pk2(v[6], v[7]);
        *(u32x4*)(p.WinT + ((size_t)l * NW + n) * DM + kc * 8) = o;
    }
    for (int l = 0; l < 2; ++l) {
        transpose_cvt(p.w_o + (size_t)l * DM * DM, p.WoT + (size_t)l * DM * DM, DM, DM, tid);
        transpose_cvt(p.w_up + (size_t)l * DM * NUP, p.WupT + (size_t)l * NUP * DM, DM, NUP, tid);
        transpose_cvt(p.w_down + (size_t)l * DFF * DM, p.WdT + (size_t)l * DM * DFF, DFF, DM, tid);
    }
    for (long i = gtid; i < 2L * 16 * 1024; i += gsz) {
        const int k = (int)(i & 1023), gi = (int)((i >> 10) & 15), l = (int)(i >> 14);
        p.WgT[i] = (bf16_t)f2bf(p.w_in[(size_t)l * DM * NIN + (size_t)k * NIN + 3072 + gi]);
    }
    for (long i = gtid; i < 4096L * 128; i += gsz) {
        const int pos = (int)(i >> 7), j = (int)(i & 127);
        const double inv = pow(10000.0, -(double)j / 128.0);
        const double ang = (double)pos * inv;
        const float c = (float)cos(ang), s = (float)sin(ang);
        p.cosT[i] = c; p.sinT[i] = s;
    }
}

DI void phase_ln(const void* srcv, const int srcmode, const bf16_t* xres,
                 const float* g, const float* b, float* dstf, bf16_t* dstb, int ntok, int tid,
                 unsigned char* smem, const float* wg, const float* bias16, float* gpre) {
    (void)smem; (void)wg; (void)bias16; (void)gpre;
    const int wid = tid >> 6, lane = tid & 63;
    const int rstride = gridDim.x * 8;
    f32x4 gvv[2][2], bvv[2][2];
#pragma unroll
    for (int q = 0; q < 2; ++q)
#pragma unroll
        for (int h = 0; h < 2; ++h) { gvv[q][h] = *(const f32x4*)(g + q * 512 + lane * 8 + h * 4); bvv[q][h] = *(const f32x4*)(b + q * 512 + lane * 8 + h * 4); }
    u32x4 na[2], nb[2];
#define LN_LOAD(r_) do { _Pragma("unroll") for (int q = 0; q < 2; ++q) { \
        if (srcmode) { na[q] = *(const u32x4*)((const bf16_t*)srcv + (size_t)(r_) * DM + q * 512 + lane * 8); nb[q] = *(const u32x4*)(xres + (size_t)(r_) * DM + q * 512 + lane * 8); } \
        else { na[q] = *(const u32x4*)((const float*)srcv + (size_t)(r_) * DM + q * 512 + lane * 8); nb[q] = *(const u32x4*)((const float*)srcv + (size_t)(r_) * DM + q * 512 + lane * 8 + 4); } } } while (0)
    {
        const int r0 = blockIdx.x * 8 + wid;
        if (r0 < ntok) LN_LOAD(r0);
    }
    for (int row = blockIdx.x * 8 + wid; row < ntok; row += rstride) {
        f32x4 v[2][2]; float s = 0.f;
#pragma unroll
        for (int q = 0; q < 2; ++q) {
            const u32x4 ra = na[q], rb = nb[q];
            if (srcmode) {
                v[q][0] = (f32x4){bflo(ra.x) + ALPHA * bflo(rb.x), bfhi(ra.x) + ALPHA * bfhi(rb.x), bflo(ra.y) + ALPHA * bflo(rb.y), bfhi(ra.y) + ALPHA * bfhi(rb.y)};
                v[q][1] = (f32x4){bflo(ra.z) + ALPHA * bflo(rb.z), bfhi(ra.z) + ALPHA * bfhi(rb.z), bflo(ra.w) + ALPHA * bflo(rb.w), bfhi(ra.w) + ALPHA * bfhi(rb.w)};
            } else { v[q][0] = __builtin_bit_cast(f32x4, ra); v[q][1] = __builtin_bit_cast(f32x4, rb); }
#pragma unroll
            for (int h = 0; h < 2; ++h) s += v[q][h][0] + v[q][h][1] + v[q][h][2] + v[q][h][3];
        }
        if (row + rstride < ntok) LN_LOAD(row + rstride);
#pragma unroll
        for (int o = 32; o >= 1; o >>= 1) s += __shfl_xor(s, o);
        const float mu = s * (1.f / 1024.f);
        float ss = 0.f;
#pragma unroll
        for (int q = 0; q < 2; ++q)
#pragma unroll
            for (int h = 0; h < 2; ++h) { v[q][h] = v[q][h] - mu; ss += v[q][h][0] * v[q][h][0] + v[q][h][1] * v[q][h][1] + v[q][h][2] * v[q][h][2] + v[q][h][3] * v[q][h][3]; }
#pragma unroll
        for (int o = 32; o >= 1; o >>= 1) ss += __shfl_xor(ss, o);
        const float rstd = rsqrtf(ss * (1.f / 1024.f) + LN_EPS);
#pragma unroll
        for (int q = 0; q < 2; ++q) {
            const f32x4 y0 = v[q][0] * rstd * gvv[q][0] + bvv[q][0], y1 = v[q][1] * rstd * gvv[q][1] + bvv[q][1];
            if (dstf) { *(f32x4*)(dstf + (size_t)row * DM + q * 512 + lane * 8) = y0; *(f32x4*)(dstf + (size_t)row * DM + q * 512 + lane * 8 + 4) = y1; }
            if (dstb) *(u32x4*)(dstb + (size_t)row * DM + q * 512 + lane * 8) = pack8(y0, y1);
        }
    }
#undef LN_LOAD
}

DI void phase_gscan(const Params& p, const float* gpre, int nchunks, int tid) {
    const int wid = tid >> 6, lane = tid & 63;
    const int tstride = gridDim.x * 8, ntask = nchunks * 8;
    float ni0 = 0.f, nf0 = 0.f, ni1 = 0.f, nf1 = 0.f;
#define GS_LOAD(task_) do { const int ch_ = (task_) >> 3, dir_ = ((task_) >> 2) & 1, head_ = (task_) & 3; \
        const int q0_ = dir_ ? 127 - 2 * lane : 2 * lane, q1_ = dir_ ? 126 - 2 * lane : 2 * lane + 1; \
        const float* r0_ = gpre + (size_t)(ch_ * 128 + q0_) * 16 + dir_ * 8 + head_; const float* r1_ = gpre + (size_t)(ch_ * 128 + q1_) * 16 + dir_ * 8 + head_; \
        ni0 = r0_[0]; nf0 = r0_[4]; ni1 = r1_[0]; nf1 = r1_[4]; } while (0)
    { const int t0 = blockIdx.x * 8 + wid; if (t0 < ntask) GS_LOAD(t0); }
    for (int task = blockIdx.x * 8 + wid; task < ntask; task += tstride) {
        const int ch = task >> 3, dir = (task >> 2) & 1, head = task & 3;
        const int p0 = dir ? 127 - 2 * lane : 2 * lane, p1 = dir ? 126 - 2 * lane : 2 * lane + 1;
        const float i0 = ni0, f0 = nf0, i1 = ni1, f1 = nf1;
        if (task + tstride < ntask) GS_LOAD(task + tstride);
        const float l0 = fminf(f0, 0.f) - log1pf(__expf(-fabsf(f0))), l1 = fminf(f1, 0.f) - log1pf(__expf(-fabsf(f1)));
        const float pair = l0 + l1;
        float inc = pair;
#pragma unroll
        for (int d = 1; d < 64; d <<= 1) { const float t = __shfl_up(inc, d); if (lane >= d) inc += t; }
        const float exc = inc - pair;
        const float c0 = exc + l0, c1 = exc + pair;
        const float b0 = i0 - c0, b1 = i1 - c1;
        float mx = fmaxf(b0, b1);
#pragma unroll
        for (int d = 1; d < 64; d <<= 1) { const float t = __shfl_up(mx, d); if (lane >= d) mx = fmaxf(mx, t); }
        float mexc = __shfl_up(mx, 1); if (lane == 0) mexc = -3.0e38f;
        const float pm0 = fmaxf(mexc, b0), pm1 = fmaxf(pm0, b1);
        float* gp = p.gates + ((size_t)(ch * 2 + dir) * 4 + head) * 384;
        gp[p0] = b0; gp[128 + p0] = pm0; gp[256 + p0] = c0;
        gp[p1] = b1; gp[128 + p1] = pm1; gp[256 + p1] = c1;
    }
#undef GS_LOAD
}

DI void phase_gates2(const Params& p, unsigned char* smem, int layer, const bf16_t* xin, int nchunks, int tid) {
    const int wid = tid >> 6, lane = tid & 63, r16 = lane & 15, kq = lane >> 4;
    float* pre = (float*)smem;
    const bf16_t* wgt = p.WgT + (size_t)layer * 16 * DM;
    for (int ch = blockIdx.x; ch < nchunks; ch += gridDim.x) {
        {
            const bf16_t* ap = xin + (size_t)(ch * 128 + wid * 16 + r16) * DM + kq * 8;
            const bf16_t* bp = wgt + (size_t)r16 * DM + kq * 8;
            f32x4 acc = {0.f, 0.f, 0.f, 0.f};
#pragma unroll 8
            for (int ks = 0; ks < 32; ++ks) {
                const bf16x8 av = *(const bf16x8*)(ap + ks * 32), bv = *(const bf16x8*)(bp + ks * 32);
                acc = __builtin_amdgcn_mfma_f32_16x16x32_bf16(av, bv, acc, 0, 0, 0);
            }
            const float bb = p.b_if[layer * 16 + r16];
#pragma unroll
            for (int r = 0; r < 4; ++r) pre[(wid * 16 + kq * 4 + r) * 17 + r16] = acc[r] + bb;
        }
        __syncthreads();
        {
            const int dir = wid >> 2, head = wid & 3;
            const int p0 = dir ? 127 - 2 * lane : 2 * lane, p1 = dir ? 126 - 2 * lane : 2 * lane + 1;
            const float i0 = pre[p0 * 17 + dir * 8 + head], f0 = pre[p0 * 17 + dir * 8 + 4 + head];
            const float i1 = pre[p1 * 17 + dir * 8 + head], f1 = pre[p1 * 17 + dir * 8 + 4 + head];
            const float l0 = fminf(f0, 0.f) - log1pf(__expf(-fabsf(f0))), l1 = fminf(f1, 0.f) - log1pf(__expf(-fabsf(f1)));
            const float pair = l0 + l1;
            float inc = pair;
#pragma unroll
            for (int d = 1; d < 64; d <<= 1) { const float t = __shfl_up(inc, d); if (lane >= d) inc += t; }
            const float exc = inc - pair;
            const float c0 = exc + l0, c1 = exc + pair;
            const float b0 = i0 - c0, b1 = i1 - c1;
            float mx = fmaxf(b0, b1);
#pragma unroll
            for (int d = 1; d < 64; d <<= 1) { const float t = __shfl_up(mx, d); if (lane >= d) mx = fmaxf(mx, t); }
            float mexc = __shfl_up(mx, 1); if (lane == 0) mexc = -3.0e38f;
            const float pm0 = fmaxf(mexc, b0), pm1 = fmaxf(pm0, b1);
            float* gp = p.gates + ((size_t)(ch * 2 + dir) * 4 + head) * 384;
            gp[p0] = b0; gp[128 + p0] = pm0; gp[256 + p0] = c0;
            gp[p1] = b1; gp[128 + p1] = pm1; gp[256 + p1] = c1;
        }
        __syncthreads();
    }
}

DI void phase_merge(const Params& p, int layer, int ntok, int tid) {
    const int wid = tid >> 6, lane = tid & 63;
    const int ch0 = lane * 16;
    const int rstride = gridDim.x * 8;
    float gav[16], gbv[16];
#pragma unroll
    for (int j = 0; j < 16; j += 4) {
        const f32x4 t0 = *(const f32x4*)(p.g_a + layer * DM + ch0 + j), t1 = *(const f32x4*)(p.g_b + layer * DM + ch0 + j);
#pragma unroll
        for (int k = 0; k < 4; ++k) { gav[j + k] = t0[k]; gbv[j + k] = t1[k]; }
    }
    u32x4 pre[8][2];
#define MERGE_LOAD(r) do { \
        const u32x4* a0 = (const u32x4*)(p.H0 + (size_t)(r) * DM + ch0); const u32x4* a1 = (const u32x4*)(p.H1 + (size_t)(r) * DM + ch0); \
        const u32x4* b0 = (const u32x4*)(p.H2 + (size_t)(r) * DM + ch0); const u32x4* b1 = (const u32x4*)(p.H3 + (size_t)(r) * DM + ch0); \
        const u32x4* e = (const u32x4*)(p.E + (size_t)(r) * 4096 + ch0); \
        _Pragma("unroll") for (int q = 0; q < 2; ++q) { pre[0][q] = a0[q]; pre[1][q] = a1[q]; pre[2][q] = b0[q]; pre[3][q] = b1[q]; pre[4][q] = e[q]; pre[5][q] = e[128 + q]; pre[6][q] = e[256 + q]; pre[7][q] = e[384 + q]; } } while (0)
    { const int r0 = blockIdx.x * 8 + wid; if (r0 < ntok) MERGE_LOAD(r0); }
    for (int row = blockIdx.x * 8 + wid; row < ntok; row += rstride) {
        float ha[16], hb[16], oa[16], gb[16], ma[16], mb[16];
        {
            u32x4 cur[8][2];
#pragma unroll
            for (int i = 0; i < 8; ++i) { cur[i][0] = pre[i][0]; cur[i][1] = pre[i][1]; }
            if (row + rstride < ntok) MERGE_LOAD(row + rstride);
#pragma unroll
            for (int q = 0; q < 2; ++q) {
                const u32x4 x0 = cur[0][q], x1 = cur[1][q], y0 = cur[2][q], y1 = cur[3][q], eo = cur[4][q], eg = cur[5][q], em = cur[6][q], en = cur[7][q];
#pragma unroll
                for (int j = 0; j < 4; ++j) {
                    ha[q * 8 + 2 * j] = bflo(x0[j]) + bflo(x1[j]); ha[q * 8 + 2 * j + 1] = bfhi(x0[j]) + bfhi(x1[j]);
                    hb[q * 8 + 2 * j] = bflo(y0[j]) + bflo(y1[j]); hb[q * 8 + 2 * j + 1] = bfhi(y0[j]) + bfhi(y1[j]);
                    oa[q * 8 + 2 * j] = bflo(eo[j]); oa[q * 8 + 2 * j + 1] = bfhi(eo[j]);
                    gb[q * 8 + 2 * j] = bflo(eg[j]); gb[q * 8 + 2 * j + 1] = bfhi(eg[j]);
                    ma[q * 8 + 2 * j] = bflo(em[j]); ma[q * 8 + 2 * j + 1] = bfhi(em[j]);
                    mb[q * 8 + 2 * j] = bflo(en[j]); mb[q * 8 + 2 * j + 1] = bfhi(en[j]);
                }
            }
        }
        float sa = 0.f, sb = 0.f;
#pragma unroll
        for (int j = 0; j < 16; ++j) { ha[j] *= sigmoidf_(oa[j]); sa += ha[j]; sb += hb[j]; }
#pragma unroll
        for (int o = 8; o >= 1; o >>= 1) { sa += __shfl_xor(sa, o); sb += __shfl_xor(sb, o); }
        const float mua = sa * (1.f / 256.f), mub = sb * (1.f / 256.f);
        float va = 0.f, vb = 0.f;
#pragma unroll
        for (int j = 0; j < 16; ++j) { ha[j] -= mua; hb[j] -= mub; va += ha[j] * ha[j]; vb += hb[j] * hb[j]; }
#pragma unroll
        for (int o = 8; o >= 1; o >>= 1) { va += __shfl_xor(va, o); vb += __shfl_xor(vb, o); }
        const float ra = rsqrtf(va * (1.f / 256.f) + LN_EPS), rb = rsqrtf(vb * (1.f / 256.f) + LN_EPS);
        unsigned ow[8];
#pragma unroll
        for (int j = 0; j < 16; j += 2) {
            float r[2];
#pragma unroll
            for (int k = 0; k < 2; ++k) {
                const float ya = ha[j + k] * ra * gav[j + k];
                const float yb = hb[j + k] * rb * gbv[j + k] * (gb[j + k] * sigmoidf_(gb[j + k]));
                r[k] = sigmoidf_(ma[j + k]) * ya + sigmoidf_(mb[j + k]) * yb;
            }
            ow[j >> 1] = pk2(r[0], r[1]);
        }
        u32x4* op = (u32x4*)(p.merged + (size_t)row * DM + ch0);
        op[0] = (u32x4){ow[0], ow[1], ow[2], ow[3]}; op[1] = (u32x4){ow[4], ow[5], ow[6], ow[7]};
    }
}

DI float gelu_tanh(float x) {
    const float u = 0.7978845608028654f * (x + 0.044715f * x * x * x);
    const float e = __expf(2.f * u);
    const float th = 1.f - 2.f * frcp(e + 1.f);
    return 0.5f * x * (1.f + th);
}
DI void phase_conv(const Params& p, int layer, int ntok, int S, int tid) {
    const float* cw = p.conv_w + (size_t)layer * 3 * NUP; const float* cbias = p.conv_b + (size_t)layer * NUP;
    const int wid = tid >> 6, lane = tid & 63;
    constexpr int SEG = 16, NCW = 11;
    const int ntask = NCW * (ntok / SEG);
    for (int task = blockIdx.x * 8 + wid; task < ntask; task += gridDim.x * 8) {
        const int cwv = task % NCW, seg = task / NCW;
        const int c = (cwv * 64 + lane) * 4;
        const int t0 = seg * SEG, pos0 = t0 % S;
        const f32x4 wv0 = *(const f32x4*)(cw + c), wv1 = *(const f32x4*)(cw + NUP + c), wv2 = *(const f32x4*)(cw + 2 * NUP + c), bv = *(const f32x4*)(cbias + c);
        const f32x4 wg0 = *(const f32x4*)(cw + DFF + c), wg1 = *(const f32x4*)(cw + NUP + DFF + c), wg2 = *(const f32x4*)(cw + 2 * NUP + DFF + c), bg = *(const f32x4*)(cbias + DFF + c);
        const bf16_t* hv = p.hu + (size_t)t0 * NUP + c; const bf16_t* hg = hv + DFF;
        bf16_t* op = p.ff + (size_t)t0 * DFF + c;
        const u32x2 z = {0u, 0u};
        u32x2 rv[SEG + 2], rg[SEG + 2];
        rv[0] = pos0 > 0 ? *(const u32x2*)(hv - NUP) : z; rg[0] = pos0 > 0 ? *(const u32x2*)(hg - NUP) : z;
#pragma unroll
        for (int i = 0; i < SEG; ++i) { rv[i + 1] = *(const u32x2*)(hv + (size_t)i * NUP); rg[i + 1] = *(const u32x2*)(hg + (size_t)i * NUP); }
        { const bool hn = (pos0 + SEG - 1) < S - 1; rv[SEG + 1] = hn ? *(const u32x2*)(hv + (size_t)SEG * NUP) : z; rg[SEG + 1] = hn ? *(const u32x2*)(hg + (size_t)SEG * NUP) : z; }
#pragma unroll
        for (int i = 0; i < SEG; ++i) {
            const u32x2 pv = rv[i], cv = rv[i + 1], nv = rv[i + 2], pg = rg[i], cg = rg[i + 1], ng = rg[i + 2];
            const f32x4 pvf = {bflo(pv.x), bfhi(pv.x), bflo(pv.y), bfhi(pv.y)}, cvf = {bflo(cv.x), bfhi(cv.x), bflo(cv.y), bfhi(cv.y)}, nvf = {bflo(nv.x), bfhi(nv.x), bflo(nv.y), bfhi(nv.y)};
            const f32x4 pgf = {bflo(pg.x), bfhi(pg.x), bflo(pg.y), bfhi(pg.y)}, cgf = {bflo(cg.x), bfhi(cg.x), bflo(cg.y), bfhi(cg.y)}, ngf = {bflo(ng.x), bfhi(ng.x), bflo(ng.y), bfhi(ng.y)};
            const f32x4 val = wv0 * pvf + wv1 * cvf + wv2 * nvf + bv;
            const f32x4 gat = wg0 * pgf + wg1 * cgf + wg2 * ngf + bg;
            u32x2 o; o.x = pk2(gelu_tanh(gat[0]) * val[0], gelu_tanh(gat[1]) * val[1]); o.y = pk2(gelu_tanh(gat[2]) * val[2], gelu_tanh(gat[3]) * val[3]);
            *(u32x2*)(op + (size_t)i * DFF) = o;
        }
    }
}

#define BAR_LDS() do { asm volatile("s_waitcnt lgkmcnt(0)" ::: "memory"); __builtin_amdgcn_s_barrier(); asm volatile("" ::: "memory"); } while (0)
#define BAR_ALL() do { asm volatile("s_waitcnt vmcnt(0) lgkmcnt(0)" ::: "memory"); __builtin_amdgcn_s_barrier(); asm volatile("" ::: "memory"); } while (0)
template <int DK, bool ML>
DI void mixer_item(const int tid_in, unsigned char* smem, int S, int nch, int seq, int head, int dir, int split,
                   const bf16_t* Qg, const bf16_t* Kg, const bf16_t* KTg, const bf16_t* VTg, bf16_t* Hout, const float* gates, float lgv) {
    constexpr int KS = DK / 16, NST = DK / 128, NKP = DK * 16 / 512;
    int tid = tid_in; asm volatile("" : "+v"(tid));
    const int wid = __builtin_amdgcn_readfirstlane(tid >> 6), lane = tid & 63, l31 = lane & 31, hh = lane >> 5;
    const int vt = wid >> 2, tb = vt ? 7 - wid : wid;
#define MK_BASES(lo, to) \
    const unsigned l31x = ((lo) >> 4) & 31u, hhx = (lo) >> 9; \
    const unsigned a_ks = (unsigned)(vt * 2 * KS * 1024) + (lo); \
    const unsigned a_vt = (unsigned)(65536 + vt * 8 * 1024) + (lo); \
    const unsigned a_cs = (unsigned)(81920 + vt * KS * 1024) + (lo); \
    const unsigned a_ps = (unsigned)(114688 + tb * 8 * 1024) + (lo); \
    const unsigned a_psw = (unsigned)(114688 + (tb * 8 + vt * 4) * 1024) + l31x * 16 + 8 * hhx; \
    const unsigned a_csw = (unsigned)(81920 + (vt * KS + tb * 2) * 1024) + l31x * 16 + 8 * hhx; \
    const unsigned a_cp = (to); \
    const unsigned a_tv = (unsigned)(147456 + tb * 128) + l31x * 4; \
    const unsigned a_sv = (unsigned)(147456 + vt * 256) + 16 * hhx; \
    const unsigned a_hv = 147456u + hhx * 32; \
    const unsigned a_th = 147456u + ((to) >> 2);
    LAS unsigned char* const L = (LAS unsigned char*)smem;
#define LDSB(addr, off) (L + (addr) + (off))
#define LDG(T, base, off) (*(const T*)((const char*)(base) + (unsigned)(off)))
#define KDMA(Kptr, i) __builtin_amdgcn_global_load_lds((const unsigned*)((const char*)(Kptr) + (unsigned)(tofs + (i) * 8192)), (LAS unsigned*)(L + (unsigned)wid * 1024u + (i) * 8192), 16, 0, 0)
    {
        unsigned lo0 = lane * 16, to0 = tid * 16; asm volatile("" : "+v"(lo0), "+v"(to0));
        MK_BASES(lo0, to0)
        (void)a_ks; (void)a_vt; (void)a_cs; (void)a_ps; (void)a_psw; (void)a_csw; (void)a_tv; (void)a_sv; (void)a_hv;
        for (int i = 0; i < 64 * DK * 2 / 16 / 512; ++i) *(LAS u32x4*)LDSB(a_cp, 81920 + i * 8192) = (u32x4){0u, 0u, 0u, 0u};
        if (tid < 128) *(LAS float*)LDSB(a_th, 7 * 512) = 0.f;
        if (ML) {
#pragma unroll
            for (int i = 0; i < 3; ++i) {
                const unsigned ones = (i == 0 && (lo0 & (31u * 16u)) == 0u) ? 0x3F803F80u : 0u;
                *(LAS u32x4*)LDSB(a_cp, 32768 + i * 8192) = (u32x4){ones, ones, ones, ones};
            }
        }
    }
    f32x16 stC[NST];
    f32x16 stX;
#pragma unroll
    for (int r = 0; r < 16; ++r) stX[r] = 0.f;
#pragma unroll
    for (int i = 0; i < NST; ++i)
#pragma unroll
        for (int r = 0; r < 16; ++r) stC[i][r] = 0.f;
    float m = 0.f;
    const int last = dir ? 0 : 127;
    const int c0 = dir ? nch - 1 : 0;
    const size_t blk0 = ((size_t)seq * nch + c0) * 4 + head;
    bf16x8 qf[KS];
    u32x4 vtr[2];
    u32x4 kst[NKP];
    bf16x8 qfn[KS];
    float g_b = 0.f, g_pm = 0.f, g_cb = 0.f, g_pml = 0.f, g_cbl = 0.f;
    {
        unsigned lofs = lane * 16, tofs = tid * 16; asm volatile("" : "+v"(lofs), "+v"(tofs));
        const bf16_t* Kf = Kg + blk0 * (size_t)(128 * DK);
        if (ML) {
#pragma unroll
            for (int i = 0; i < NKP; ++i) kst[i] = LDG(u32x4, Kf, tofs + i * 8192);
        } else {
#pragma unroll
            for (int i = 0; i < NKP; ++i) KDMA(Kf, i);
        }
        const bf16_t* Qf = Qg + blk0 * (size_t)(128 * DK);
#pragma unroll
        for (int ks = 0; ks < KS; ++ks) qf[ks] = LDG(bf16x8, Qf + tb * KS * 512, lofs + ks * 1024);
        const bf16_t* VTf = VTg + blk0 * (size_t)(256 * 128) + split * (2 * 8 * 512);
#pragma unroll
        for (int i = 0; i < 2; ++i) vtr[i] = LDG(u32x4, VTf, tofs + i * 8192);
        if (ML) {
            const float* gp = gates + (((size_t)seq * nch + c0) * 2 + dir) * 4 * 384 + head * 384;
            g_pml = gp[128 + last]; g_cbl = gp[256 + last];
            if (tid < 128) { g_b = gp[tid]; g_pm = gp[128 + tid]; g_cb = gp[256 + tid]; }
        }
    }
    for (int ci = 0; ci < nch; ++ci) {
        const int c = dir ? nch - 1 - ci : ci;
        const bool has_next = ci + 1 < nch;
        unsigned lofs = lane * 16, tofs = tid * 16; asm volatile("" : "+v"(lofs), "+v"(tofs));
        float lgl = lgv; asm volatile("" : "+v"(lgl));
        const float rstep = ML ? 1.f : __expf(dir ? lgl : -lgl);
        MK_BASES(lofs, tofs)
        const int cn = dir ? c - 1 : c + 1;
        const size_t blk = ((size_t)seq * nch + c) * 4 + head;
        const size_t blkn = ((size_t)seq * nch + (has_next ? cn : c)) * 4 + head;
        const bf16_t* KTf = KTg + blk * (size_t)(DK * 128);
        const bf16_t* Kfn = Kg + blkn * (size_t)(128 * DK);
        if (ML) {
#pragma unroll
            for (int i = 0; i < NKP; ++i) *(LAS u32x4*)LDSB(a_cp, i * 8192) = kst[i];
        }
#pragma unroll
        for (int i = 0; i < 2; ++i) *(LAS u32x4*)LDSB(a_cp, 65536 + i * 8192) = vtr[i];
        float dec, m_new = 0.f;
        if (ML) {
            const float Ml = fmaxf(m, g_pml);
            dec = __expf(m - Ml); m_new = g_cbl + Ml;
            if (tid < 128) {
                const float M = fmaxf(m, g_pm);
                *(LAS float*)LDSB(a_th, 0) = g_b * 1.44269504089f; *(LAS float*)LDSB(a_th, 512) = M * 1.44269504089f; *(LAS float*)LDSB(a_th, 1024) = __expf(m - M);
                *(LAS float*)LDSB(a_th, 1536) = __expf(-g_cb - M); *(LAS float*)LDSB(a_th, 2048) = __expf(g_b - Ml); *(LAS float*)LDSB(a_th, 2560) = 0.f;
            }
        } else {
            dec = __expf(lgv * 128.f);
            if (ci == 0 && tid < 128) { *(LAS float*)LDSB(a_th, 1024) = __expf(lgv * (float)(dir ? (128 - tid) : (tid + 1))); *(LAS float*)LDSB(a_th, 2048) = __expf(lgv * (float)(dir ? tid : (127 - tid))); }
        }
        BAR_ALL();
        {
            float rsp = 0.f;
            const int t = tb * 32 + (int)l31x;
            const float Mtt = ML ? *(const LAS float*)LDSB(a_tv, 512) : 0.f;
#pragma unroll
            for (int sbi = 0; sbi < 2; ++sbi) {
                const int sb = vt * 2 + sbi;
                if (dir ? (sb < tb) : (sb > tb)) continue;
                f32x16 acc;
#pragma unroll
                for (int r = 0; r < 16; ++r) acc[r] = 0.f;
                {
                    bf16x8 fb[2][4];
#pragma unroll
                    for (int j = 0; j < 4; ++j) fb[0][j] = *(const LAS bf16x8*)LDSB(a_ks, (sbi * KS + j) * 1024);
#pragma unroll
                    for (int g = 0; g < KS / 4; ++g) {
                        if (g + 1 < KS / 4) {
#pragma unroll
                            for (int j = 0; j < 4; ++j) fb[(g + 1) & 1][j] = *(const LAS bf16x8*)LDSB(a_ks, (sbi * KS + (g + 1) * 4 + j) * 1024);
                        }
                        __builtin_amdgcn_sched_barrier(0);
#pragma unroll
                        for (int j = 0; j < 4; ++j) acc = MFMA32(fb[g & 1][j], qf[g * 4 + j], acc);
                        __builtin_amdgcn_sched_barrier(0);
                    }
                }
                const int mb = dir ? (t - sb * 32 - 4 * (int)hhx) : (sb * 32 + 4 * (int)hhx - t);
                float wk = 0.f, wr = 0.f;
                if (!ML) { wk = __expf(-lgl * (float)mb); wr = rstep; }
#pragma unroll
                for (int q = 0; q < 4; ++q) {
                    float v[4];
                    f32x4 bs4 = {0.f, 0.f, 0.f, 0.f};
                    if (ML) bs4 = *(const LAS f32x4*)LDSB(a_sv, (sbi * 32 + 8 * q) * 4);
#pragma unroll
                    for (int jj = 0; jj < 4; ++jj) {
                        const int k = 8 * q + jj;
                        const bool ok = mb <= (dir ? k : -k);
                        const float w = ML ? __builtin_amdgcn_exp2f(bs4[jj] - Mtt) : wk;
                        v[jj] = ok ? acc[q * 4 + jj] * w : 0.f;
                        rsp += v[jj];
                        if (!ML) wk *= wr;
                    }
                    if (!ML) { wk *= wr; wk *= wr; wk *= wr; wk *= wr; }
                    u32x2 o; o.x = pk2(v[0], v[1]); o.y = pk2(v[2], v[3]);
                    *(LAS u32x2*)LDSB(a_psw, (sbi * 2 + (q >> 1)) * 1024 + (q & 1) * 512) = o;
                }
            }
            (void)rsp;
        }
        BAR_LDS();
        if (has_next) {
            if (ML) {
#pragma unroll
                for (int i = 0; i < NKP; ++i) kst[i] = LDG(u32x4, Kfn, tofs + i * 8192);
                const bf16_t* Qfn = Qg + blkn * (size_t)(128 * DK);
#pragma unroll
                for (int ks = 0; ks < KS; ++ks) qfn[ks] = LDG(bf16x8, Qfn + tb * KS * 512, lofs + ks * 1024);
                const bf16_t* VTfn = VTg + blkn * (size_t)(256 * 128) + split * (2 * 8 * 512);
#pragma unroll
                for (int i = 0; i < 2; ++i) vtr[i] = LDG(u32x4, VTfn, tofs + i * 8192);
                const float* gp = gates + (((size_t)seq * nch + cn) * 2 + dir) * 4 * 384 + head * 384;
                g_pml = gp[128 + last]; g_cbl = gp[256 + last];
                if (tid < 128) { g_b = gp[tid]; g_pm = gp[128 + tid]; g_cb = gp[256 + tid]; }
            } else {
#pragma unroll
                for (int i = 0; i < NKP; ++i) KDMA(Kfn, i);
            }
        }
        bf16x8 kt[8];
        {
            f32x16 a1, a2;
#pragma unroll
            for (int r = 0; r < 16; ++r) { a1[r] = 0.f; a2[r] = 0.f; }
            f32x16 a1x, a2x;
#pragma unroll
            for (int r = 0; r < 16; ++r) { a1x[r] = 0.f; a2x[r] = 0.f; }
            {
#pragma unroll
                for (int g = 0; g < 4; ++g) {
                    if (dir ? (g < tb) : (g > tb)) continue;
                    const bf16x8 fa0 = *(const LAS bf16x8*)LDSB(a_vt, (g * 2) * 1024), fa1 = *(const LAS bf16x8*)LDSB(a_vt, (g * 2 + 1) * 1024);
                    const bf16x8 fp0 = *(const LAS bf16x8*)LDSB(a_ps, (g * 2) * 1024), fp1 = *(const LAS bf16x8*)LDSB(a_ps, (g * 2 + 1) * 1024);
                    a1 = MFMA32(fa0, fp0, a1); a1 = MFMA32(fa1, fp1, a1);
                    if (ML) {
                        const bf16x8 fx0 = *(const LAS bf16x8*)(L + lofs + 32768u + (g * 2) * 1024), fx1 = *(const LAS bf16x8*)(L + lofs + 32768u + (g * 2 + 1) * 1024);
                        a1x = MFMA32(fx0, fp0, a1x); a1x = MFMA32(fx1, fp1, a1x);
                    }
                }
                bf16x8 fc[2][4];
#pragma unroll
                for (int j = 0; j < 4; ++j) fc[0][j] = *(const LAS bf16x8*)LDSB(a_cs, j * 1024);
#pragma unroll
                for (int g = 0; g < KS / 4; ++g) {
                    if (g + 1 < KS / 4) {
#pragma unroll
                        for (int j = 0; j < 4; ++j) fc[(g + 1) & 1][j] = *(const LAS bf16x8*)LDSB(a_cs, ((g + 1) * 4 + j) * 1024);
                    }
                    __builtin_amdgcn_sched_barrier(0);
#pragma unroll
                    for (int j = 0; j < 4; ++j) a2 = MFMA32(fc[g & 1][j], qf[g * 4 + j], a2);
                    __builtin_amdgcn_sched_barrier(0);
                }
            }
            if (ML) {
#pragma unroll
                for (int ks = 0; ks < KS; ++ks) { const bf16x8 fcx = *(const LAS bf16x8*)(L + lofs + 49152u + ks * 1024); a2x = MFMA32(fcx, qf[ks], a2x); }
            }
#pragma unroll
            for (int ks = 0; ks < 8; ++ks) kt[ks] = LDG(bf16x8, KTf + tb * 8 * 512, lofs + ks * 1024);
            const int t = tb * 32 + (int)l31x; const float wi = *(const LAS float*)LDSB(a_tv, 2 * 512); float inv = 1.f;
            if (ML) { const float d0v = a1x[0] + wi * a2x[0]; const float dsw = __shfl_xor(d0v, 32); const float den = hhx ? dsw : d0v; inv = frcp(fmaxf(fabsf(den), *(const LAS float*)LDSB(a_tv, 3 * 512))); }
            bf16_t* hp = Hout + ((size_t)seq * S + (size_t)c * 128 + t) * DM + head * 256 + split * 64 + vt * 32 + 4 * (int)hhx;
#pragma unroll
            for (int q = 0; q < 4; ++q) {
                u32x2 o; o.x = pk2((a1[q * 4] + wi * a2[q * 4]) * inv, (a1[q * 4 + 1] + wi * a2[q * 4 + 1]) * inv);
                o.y = pk2((a1[q * 4 + 2] + wi * a2[q * 4 + 2]) * inv, (a1[q * 4 + 3] + wi * a2[q * 4 + 3]) * inv);
                *(u32x2*)(hp + 8 * q) = o;
            }
        }
        BAR_LDS();
        if (!ML && has_next) {
            const bf16_t* VTfn = VTg + blkn * (size_t)(256 * 128) + split * (2 * 8 * 512);
#pragma unroll
            for (int i = 0; i < 2; ++i) vtr[i] = LDG(u32x4, VTfn, tofs + i * 8192);
        }
#pragma unroll
        for (int i = 0; i < 2; ++i) {
            const unsigned pidx = (unsigned)i * 512u + (tofs >> 4);
            const unsigned s0 = ((pidx >> 6) & 7u) * 16u + ((pidx >> 5) & 1u) * 8u;
            const u32x4 vv = *(const LAS u32x4*)LDSB(a_cp, 65536 + i * 8192);
            const f32x4 w0 = *(const LAS f32x4*)(L + 147456u + 4u * 512u + s0 * 4u), w1 = *(const LAS f32x4*)(L + 147456u + 4u * 512u + s0 * 4u + 16u);
            u32x4 o;
            o.x = pk2(bflo(vv.x) * w0[0], bfhi(vv.x) * w0[1]); o.y = pk2(bflo(vv.y) * w0[2], bfhi(vv.y) * w0[3]);
            o.z = pk2(bflo(vv.z) * w1[0], bfhi(vv.z) * w1[1]); o.w = pk2(bflo(vv.w) * w1[2], bfhi(vv.w) * w1[3]);
            *(LAS u32x4*)LDSB(a_cp, 114688 + i * 8192) = o;
        }
        if (ML && tid < 16) {
            const unsigned s0 = (unsigned)(tid >> 1) * 16u + (unsigned)(tid & 1) * 8u;
            const f32x4 w0 = *(const LAS f32x4*)(L + 147456u + 4u * 512u + s0 * 4u), w1 = *(const LAS f32x4*)(L + 147456u + 4u * 512u + s0 * 4u + 16u);
            u32x4 o; o.x = pk2(w0[0], w0[1]); o.y = pk2(w0[2], w0[3]); o.z = pk2(w1[0], w1[1]); o.w = pk2(w1[2], w1[3]);
            *(LAS u32x4*)(L + 40960u + ((unsigned)(tid >> 1) * 64u + 32u * (unsigned)(tid & 1)) * 16u) = o;
        }
        BAR_LDS();
        bf16x8 fv[8];
#pragma unroll
        for (int ks = 0; ks < 8; ++ks) fv[ks] = *(const LAS bf16x8*)LDSB(a_vt, (114688 - 65536) + ks * 1024);
#pragma unroll
        for (int i = 0; i < NST; ++i) {
            bf16x8 ktn[8];
            if (i + 1 < NST) {
#pragma unroll
                for (int ks = 0; ks < 8; ++ks) ktn[ks] = LDG(bf16x8, KTf + (tb + 4 * (i + 1)) * 8 * 512, lofs + ks * 1024);
            }
            if (ML && vt == 0) {
#pragma unroll
                for (int r = 0; r < 16; ++r) stX[r] *= dec;
#pragma unroll
                for (int ks = 0; ks < 8; ++ks) { const bf16x8 fw = *(const LAS bf16x8*)(L + lofs + 40960u + ks * 1024); stX = MFMA32(kt[ks], fw, stX); }
#pragma unroll
                for (int q = 0; q < 4; ++q) {
                    u32x2 o; o.x = pk2(stX[q * 4], stX[q * 4 + 1]); o.y = pk2(stX[q * 4 + 2], stX[q * 4 + 3]);
                    *(LAS u32x2*)(L + 49152u + (unsigned)((tb * 2 + (q >> 1)) * 1024 + (q & 1) * 512) + l31x * 16u + 8u * hhx) = o;
                }
            }
#pragma unroll
            for (int r = 0; r < 16; ++r) stC[i][r] *= dec;
            __builtin_amdgcn_sched_barrier(0);
#pragma unroll
            for (int ks = 0; ks < 8; ++ks) stC[i] = MFMA32(kt[ks], fv[ks], stC[i]);
            __builtin_amdgcn_sched_barrier(0);
#pragma unroll
            for (int q = 0; q < 4; ++q) {
                u32x2 o; o.x = pk2(stC[i][q * 4], stC[i][q * 4 + 1]); o.y = pk2(stC[i][q * 4 + 2], stC[i][q * 4 + 3]);
                *(LAS u32x2*)LDSB(a_csw, (8 * i + (q >> 1)) * 1024 + (q & 1) * 512) = o;
            }
            if (i + 1 < NST) {
#pragma unroll
                for (int ks = 0; ks < 8; ++ks) kt[ks] = ktn[ks];
            }
            if (NST > 1 && i == 0 && has_next) {
                const bf16_t* Qfn = Qg + blkn * (size_t)(128 * DK);
#pragma unroll
                for (int ks = 0; ks < KS; ++ks) qf[ks] = LDG(bf16x8, Qfn + tb * KS * 512, lofs + ks * 1024);
            }
        }
        if (ML && has_next) {
#pragma unroll
            for (int ks = 0; ks < KS; ++ks) qf[ks] = qfn[ks];
        }
        if (ML) m = m_new;
        BAR_LDS();
    }
#undef LDSB
#undef KDMA
#undef LDG
#undef MK_BASES
}

DI void phase_mixer(const Params& p, unsigned char* smem, int layer, int S, int nseq, int tid) {
    const int nch = S / 128, NI = nseq * 32;
    for (int it = blockIdx.x; it < 2 * NI; it += gridDim.x) {
        const int mixer = it / NI, r = it % NI;
        const int head = r & 3, dir = (r >> 2) & 1, split = (r >> 3) & 3, seq = r >> 5;
        if (mixer == 0) mixer_item<256, false>(tid, smem, S, nch, seq, head, dir, split, p.Qb, p.Kb, p.KbT, p.VbT, dir ? p.H3 : p.H2, nullptr, p.lg[layer * 8 + dir * 4 + head]);
        else mixer_item<128, true>(tid, smem, S, nch, seq, head, dir, split, p.Qa, p.Ka, p.KaT, p.VaT, dir ? p.H1 : p.H0, p.gates, 0.f);
    }
}


#define XB_TMO      128
#define XB_XCNT(j)  (256  + 64 * (j))
#define XB_XSUB(j)  (1280 + 64 * (j))
#define XB_XGEN(j)  (2304 + 64 * (j))
#define XB_TOP      3328
#define XB_TOPGEN   3392
#define XCD_BAR_WORDS 3456
#define XB_SPIN_CAP (1u << 22)
DI unsigned xb_ld(unsigned* p)              { return __hip_atomic_load(p, __ATOMIC_RELAXED, __HIP_MEMORY_SCOPE_AGENT); }
DI unsigned xb_add(unsigned* p, unsigned v) { return __hip_atomic_fetch_add(p, v, __ATOMIC_RELAXED, __HIP_MEMORY_SCOPE_AGENT); }
DI unsigned xb_xcc_id() { return (unsigned)__builtin_amdgcn_s_getreg((3 << 11) | 20) & 0xFu; }
#define XB_SPIN(cond, bar) do { unsigned _sp = 0; while (cond) { __builtin_amdgcn_s_sleep(1); \
    if ((++_sp & 255u) == 0u) { if (xb_ld(&(bar)[XB_TMO])) break; if (_sp > XB_SPIN_CAP) { atomicAdd(&(bar)[XB_TMO], 1u); break; } } } } while (0)
struct XcdBarrier { unsigned* bar; unsigned x; volatile LAS unsigned* st; };
DI XcdBarrier xcd_barrier_post(unsigned* bar, volatile LAS unsigned* st, int tid) {
    XcdBarrier b; b.bar = bar; b.x = xb_xcc_id(); b.st = st;
    if (tid == 0) (void)xb_add(&bar[XB_XCNT(b.x)], 1u);
    return b;
}
DI void xcd_barrier_complete(unsigned* bar, unsigned x, unsigned& nloc, unsigned& nx) {
    const unsigned G = gridDim.x * gridDim.y * gridDim.z;
    unsigned sum, cnt, mine, sp = 0u;
    for (;;) {
        sum = 0u; cnt = 0u; mine = 0u;
#pragma unroll
        for (unsigned j = 0; j < 16; ++j) { const unsigned c = xb_ld(&bar[XB_XCNT(j)]); sum += c; cnt += (c > 0u) ? 1u : 0u; mine = (j == x) ? c : mine; }
        if (sum == G) break;
        __builtin_amdgcn_s_sleep(1);
        if ((++sp & 255u) == 0u) { if (xb_ld(&bar[XB_TMO])) break; if (sp > XB_SPIN_CAP) { atomicAdd(&bar[XB_TMO], 1u); break; } }
    }
    nloc = mine > 0u ? mine : 1u; nx = cnt > 0u ? cnt : 1u;
}
DI void xcd_barrier(const XcdBarrier& b, int tid) {
    asm volatile("s_waitcnt vmcnt(0)" ::: "memory");
    __syncthreads();
    if (tid == 0) {
        unsigned* bar = b.bar;
        __builtin_amdgcn_s_waitcnt(0);
        unsigned nloc = b.st[0], nx = b.st[1];
        if (nloc == 0u) { xcd_barrier_complete(bar, b.x, nloc, nx); b.st[0] = nloc; b.st[1] = nx; }
        const unsigned old = xb_add(&bar[XB_XSUB(b.x)], 1u);
        const unsigned gen = old / nloc;
        if (old + 1u == (gen + 1u) * nloc) {
            __builtin_amdgcn_fence(__ATOMIC_RELEASE, "agent");
            asm volatile("s_waitcnt vmcnt(0)" ::: "memory");
            const unsigned og = xb_add(&bar[XB_TOP], 1u);
            const unsigned tg = og / nx;
            if (og + 1u == (tg + 1u) * nx) xb_add(&bar[XB_TOPGEN], 1u);
            else XB_SPIN(xb_ld(&bar[XB_TOPGEN]) == tg, bar);
            __builtin_amdgcn_fence(__ATOMIC_ACQUIRE, "agent");
            xb_add(&bar[XB_XGEN(b.x)], 1u);
            asm volatile("s_waitcnt vmcnt(0)" ::: "memory");
        } else {
            XB_SPIN(xb_ld(&bar[XB_XGEN(b.x)]) == gen, bar);
            __builtin_amdgcn_fence(__ATOMIC_ACQUIRE, "agent");
            asm volatile("s_waitcnt vmcnt(0)" ::: "memory");
        }
    }
    __syncthreads();
}

DI size_t al256(size_t x) { return (x + 255) & ~(size_t)255; }
DI void build_params(Params& p, const KArgs& a, char* w, int G) {
    p.x_prompt = a.in[0]; p.x_sample = a.in[1]; p.ln_in_g = a.in[2]; p.ln_in_b = a.in[3]; p.w_in = a.in[4]; p.b_if = a.in[5]; p.lg = a.in[6]; p.g_a = a.in[7]; p.g_b = a.in[8];
    p.w_o = a.in[9]; p.ln1_g = a.in[10]; p.ln1_b = a.in[11]; p.w_up = a.in[12]; p.conv_w = a.in[13]; p.conv_b = a.in[14]; p.w_down = a.in[15]; p.ln2_g = a.in[16]; p.ln2_b = a.in[17];
    p.out = a.out; p.G = G; p.pad = 0;
    size_t o = 0;
    p.WinT = (bf16_t*)(w + o); o += al256((size_t)2 * NW * DM * 2);
    p.WoT = (bf16_t*)(w + o); o += al256((size_t)2 * DM * DM * 2);
    p.WupT = (bf16_t*)(w + o); o += al256((size_t)2 * NUP * DM * 2);
    p.WdT = (bf16_t*)(w + o); o += al256((size_t)2 * DM * DFF * 2);
    p.cosT = (float*)(w + o); o += (size_t)4096 * 128 * 4; p.sinT = (float*)(w + o); o += (size_t)4096 * 128 * 4;
    p.cosTT = (float*)(w + o); o += (size_t)4096 * 128 * 4; p.sinTT = (float*)(w + o); o += (size_t)4096 * 128 * 4;
    p.gates = (float*)(w + o); o += (size_t)G * 96;
    p.gpre = (float*)(w + o); o += (size_t)G * 64;
    p.WgT = (bf16_t*)(w + o); o += 65536;
    char* ubase = w + o;
    const size_t g1 = (size_t)G * 1024;
    p.Qb = (bf16_t*)(w + o); o += 2 * g1; p.Kb = (bf16_t*)(w + o); o += 2 * g1;
    p.Qa = (bf16_t*)(w + o); o += g1; p.Ka = (bf16_t*)(w + o); o += g1;
    p.E = (bf16_t*)(w + o); o += 8 * g1;
    p.KbT = (bf16_t*)(w + o); o += 2 * g1; p.KaT = (bf16_t*)(w + o); o += g1;
    p.VaT = (bf16_t*)(w + o); o += 2 * g1; p.VbT = (bf16_t*)(w + o); o += 2 * g1;
    p.H0 = (bf16_t*)(w + o); o += 2 * g1; p.H1 = (bf16_t*)(w + o); o += 2 * g1;
    p.H2 = (bf16_t*)(w + o); o += 2 * g1; p.H3 = (bf16_t*)(w + o); o += 2 * g1;
    p.xb = p.H0; p.merged = (bf16_t*)ubase; p.hu = (bf16_t*)ubase; p.ff = (bf16_t*)(ubase + (size_t)G * NUP * 2);
}
DI void run_phase(const Params& p, unsigned char* smem, int ph, const int tid) {
    const int G = p.G;
    const int g = (ph - 1) / 19, q = (ph - 1) % 19;
    const int T0 = g * G;
    const int S = T0 < TPROMPT ? 2048 : 4096;
    const int nseq = G / S;
    float* xg = p.out + (size_t)T0 * DM;
    bf16_t* xin = (bf16_t*)xg;
    bf16_t* yb = p.H2;
    LAS unsigned char* lds = (LAS unsigned char*)smem;
    if (q == 0) return;
    const int l = (q - 1) / 9, k = (q - 1) % 9;
    pg8::StaticOrder so;
    switch (k) {
    case 0: {
        { pg8::Gemm gm{xin, p.WinT + (size_t)l * NW * DM, G, NNORM, DM}; so.init(gm.M, gm.N, (int)gridDim.x, (int)blockIdx.x); EpiInN e{&p, S, smem}; pg8::gemm_phase(lds, gm, so, e, tid); }
        { pg8::Gemm gm{p.WinT + ((size_t)l * NW + NNORM) * DM, xin, NTR, G, DM}; so.init(gm.M, gm.N, (int)gridDim.x, (int)blockIdx.x); EpiInT e{&p, S}; pg8::gemm_phase(lds, gm, so, e, tid); }
        phase_gates2(p, smem, l, xin, G / 128, tid);
    } break;
    case 1: phase_mixer(p, smem, l, S, nseq, tid); break;
    case 2: phase_merge(p, l, G, tid); break;
    case 3: { pg8::Gemm gm{p.merged, p.WoT + (size_t)l * DM * DM, G, DM, DM}; so.init(gm.M, gm.N, (int)gridDim.x, (int)blockIdx.x); EpiB16 e{yb, DM}; pg8::gemm_phase(lds, gm, so, e, tid); } break;
    case 4: phase_ln(yb, 2, xin, p.ln1_g + l * DM, p.ln1_b + l * DM, nullptr, p.xb, G, tid, smem, nullptr, nullptr, nullptr); break;
    case 5: { pg8::Gemm gm{p.xb, p.WupT + (size_t)l * NUP * DM, G, NUP, DM}; so.init(gm.M, gm.N, (int)gridDim.x, (int)blockIdx.x); EpiB16 e{p.hu, NUP}; pg8::gemm_phase(lds, gm, so, e, tid); } break;
    case 6: phase_conv(p, l, G, S, tid); break;
    case 7: { pg8::Gemm gm{p.ff, p.WdT + (size_t)l * DM * DFF, G, DM, DFF}; so.init(gm.M, gm.N, (int)gridDim.x, (int)blockIdx.x); EpiB16 e{yb, DM}; pg8::gemm_phase(lds, gm, so, e, tid); } break;
    default: {
        const int T1 = T0 + G;
        const int nrep = (l == 1 && T1 < TTOT) ? 2 : 1;
        _Pragma("nounroll") for (int rep = 0; rep < nrep; ++rep) {
            const void* src; const float* gg; const float* bb; float* df; bf16_t* db;
            if (rep == 0) { src = yb; gg = p.ln2_g + l * DM; bb = p.ln2_b + l * DM; df = l == 1 ? xg : nullptr; db = l == 1 ? nullptr : xin; }
            else { src = T1 < TPROMPT ? p.x_prompt + (size_t)T1 * DM : p.x_sample + (size_t)(T1 - TPROMPT) * DM; gg = p.ln_in_g; bb = p.ln_in_b; df = nullptr; db = (bf16_t*)(p.out + (size_t)T1 * DM); }
            phase_ln(src, rep == 0 ? 2 : 0, p.xb, gg, bb, df, db, G, tid, smem, nullptr, nullptr, nullptr);
        }
    } break;
    }
}

__global__ __launch_bounds__(512, 2) void mega(KArgs a, int ph_lo, int ph_hi) {
    extern __shared__ __attribute__((aligned(16))) unsigned char smem[];
    const int wid0 = __builtin_amdgcn_readfirstlane((int)threadIdx.x >> 6);
#define MK_TID() (wid0 * 64 + (int)__builtin_amdgcn_mbcnt_hi(~0u, __builtin_amdgcn_mbcnt_lo(~0u, 0u)))
    const bool multi = ph_hi - ph_lo > 1;
    XcdBarrier xb; xb.bar = a.bar; xb.x = 0; xb.st = (volatile LAS unsigned*)((LAS unsigned char*)smem + 151552);
    if (multi) {
        int tid1 = MK_TID(); asm volatile("" : "+v"(tid1));
        if (tid1 == 0) { xb.st[0] = 0u; xb.st[1] = 0u; }
        __syncthreads();
        xb = xcd_barrier_post(a.bar, xb.st, tid1);
    }
    if (ph_hi < -1000) cg::this_grid().sync();
    if (ph_lo == 0) {
        int tid0 = MK_TID(); asm volatile("" : "+v"(tid0));
        Params p; build_params(p, a, a.ws, a.G);
        phase_prep(p, tid0);
        phase_ln(p.x_prompt, 0, nullptr, p.ln_in_g, p.ln_in_b, nullptr, (bf16_t*)p.out, a.G, tid0, smem, nullptr, nullptr, nullptr);
        ph_lo = 1;
        if (ph_lo < ph_hi) xcd_barrier(xb, tid0);
    }
    for (int ph = ph_lo; ph < ph_hi; ++ph) {
        int wq = wid0; asm volatile("" : "+s"(wq));
        int tid = wq * 64 + (int)__builtin_amdgcn_mbcnt_hi(~0u, __builtin_amdgcn_mbcnt_lo(~0u, 0u)); asm volatile("" : "+v"(tid));
        int G = a.G; char* w = a.ws; asm volatile("" : "+s"(G));
        Params p; build_params(p, a, w, G);
        if ((ph - 1) % 19 == 0) continue;
        run_phase(p, smem, ph, tid);
        if (ph + 1 < ph_hi) xcd_barrier(xb, tid);
    }
}

#ifndef ONE_LAUNCH
#define ONE_LAUNCH 1
#endif

extern "C" void kernel_launch(void* const* d_in, const int* in_sizes, int n_in, void* d_out, int out_size, void* d_ws, size_t ws_size, hipStream_t stream) {
    static int grid = 0;
    if (grid == 0) {
        int dev = 0, cus = 0, per_cu = 0;
        hipGetDevice(&dev);
        hipDeviceGetAttribute(&cus, hipDeviceAttributeMultiprocessorCount, dev);
        hipFuncSetAttribute((const void*)mega, hipFuncAttributeMaxDynamicSharedMemorySize, LDS_BYTES);
        hipOccupancyMaxActiveBlocksPerMultiprocessor(&per_cu, (const void*)mega, 512, LDS_BYTES);
        (void)hipGetLastError();
        if (per_cu < 1) per_cu = 1;
        if (cus <= 0) cus = 256;
        grid = cus;
    }
    KArgs p{};
    for (int i = 0; i < 18; ++i) p.in[i] = (const float*)d_in[i];
    p.out = (float*)d_out; p.ws = (char*)d_ws + 16384; p.bar = (unsigned*)d_ws;
    auto need = [](size_t G) { return (size_t)2 * NW * DM * 2 + (size_t)2 * DM * DM * 2 + (size_t)2 * NUP * DM * 2 + (size_t)2 * DM * DFF * 2 + (size_t)4 * 4096 * 128 * 4 + G * 160 + G * (size_t)(NW) * 2 + G * (size_t)4 * DM * 2 + 4096 + 16384 + 65536; };
    int G = 32768;
    if (need(G) > ws_size) G = 16384;
    p.G = G;
    const int ngroups = TTOT / G;
    const int nph = 1 + ngroups * 19;
#if ONE_LAUNCH
    hipMemsetAsync(d_ws, 0, 16384, stream);
    int lo = 0, hi = nph;
    void* args[] = {&p, &lo, &hi};
    hipError_t e = hipLaunchCooperativeKernel((const void*)mega, dim3(grid), dim3(512), args, LDS_BYTES, stream);
    if (e != hipSuccess) fprintf(stderr, "cooperative launch failed: %s (grid %d)\n", hipGetErrorString(e), grid);
#else
    for (int ph = 0; ph < nph; ++ph) hipLaunchKernelGGL(mega, dim3(grid), dim3(512), LDS_BYTES, stream, p, ph, ph + 1);
#endif
}
```

```cpp
#include <hip/hip_runtime.h>
#include <hip/hip_cooperative_groups.h>
#include <cstdio>
namespace cg = cooperative_groups;

#define LAS __attribute__((address_space(3)))
#define DI __device__ __forceinline__
typedef unsigned short bf16_t;
typedef short bf16x8 __attribute__((ext_vector_type(8)));
typedef float f32x4 __attribute__((ext_vector_type(4)));
typedef float f32x16 __attribute__((ext_vector_type(16)));
typedef unsigned u32x4 __attribute__((ext_vector_type(4)));
typedef unsigned u32x2 __attribute__((ext_vector_type(2)));

constexpr int DM = 1024, NIN = 9232, DFF = 2816, NUP = 5632;
constexpr int NNORM = 7168, NTR = 2048, NW = NNORM + NTR;
constexpr int TTOT = 98304, TPROMPT = 65536;
constexpr int LDS_BYTES = 151552 + 16;
constexpr float ALPHA = 1.41421356237f;
constexpr float LN_EPS = 1e-5f;

struct KArgs {
    const float* in[18];
    float* out; char* ws; unsigned* bar;
    int G; int pad;
};
struct Params {
    const float* x_prompt; const float* x_sample; const float* ln_in_g; const float* ln_in_b; const float* w_in; const float* b_if;
    const float* lg; const float* g_a; const float* g_b; const float* w_o; const float* ln1_g; const float* ln1_b; const float* w_up;
    const float* conv_w; const float* conv_b; const float* w_down; const float* ln2_g; const float* ln2_b;
    float* out;
    bf16_t* WinT; bf16_t* WoT; bf16_t* WupT; bf16_t* WdT;
    float* cosT; float* sinT; float* cosTT; float* sinTT;
    float* gates; float* gpre; bf16_t* WgT;
    bf16_t* Qb; bf16_t* Kb; bf16_t* Qa; bf16_t* Ka; bf16_t* E; bf16_t* KbT; bf16_t* KaT; bf16_t* VaT; bf16_t* VbT;
    bf16_t* H0; bf16_t* H1; bf16_t* H2; bf16_t* H3;
    bf16_t* xb; bf16_t* merged; bf16_t* hu; bf16_t* ff;
    int G; int pad;
};

typedef float f32x2 __attribute__((ext_vector_type(2)));
typedef __bf16 bf16v2 __attribute__((ext_vector_type(2)));
DI unsigned f2bf(float x) { unsigned u = __float_as_uint(x); u += 0x7fffu + ((u >> 16) & 1u); return u >> 16; }
DI unsigned pk2(float lo, float hi) { const f32x2 v = {lo, hi}; return __builtin_bit_cast(unsigned, __builtin_convertvector(v, bf16v2)); }
DI float bflo(unsigned w) { return __uint_as_float(w << 16); }
DI float bfhi(unsigned w) { return __uint_as_float(w & 0xffff0000u); }
DI float frcp(float x) { return __builtin_amdgcn_rcpf(x); }
DI float sigmoidf_(float x) { return frcp(1.f + __expf(-x)); }
#define MFMA32(a, b, c) __builtin_amdgcn_mfma_f32_32x32x16_bf16((a), (b), (c), 0, 0, 0)

namespace pg8 {
constexpr int BM = 256, BK = 64, HALF = 128, HTB = HALF * BK * 2, STAGE_BYTES = 8 * HTB, NXCD = 8, WGM = 8;
DI int lds_byte(int r, int c) { const int st = (r >> 4) * 2 + (c >> 5), rr = r & 15, cc = c & 31, ob = rr * 64 + cc * 2; return st * 1024 + (ob ^ (((ob >> 9) & 1) << 5)); }
DI void stage_rc(int b, int& R, int& C) { const int st = b / 1024, sb = b % 1024, swz = sb ^ (((sb >> 9) & 1) << 5); R = (st >> 1) * 16 + swz / 64; C = (st & 1) * 32 + (swz % 64) / 2; }
DI int perm32(int rho) { const int n = rho >> 4, i = rho & 15; return 8 * (i >> 2) + 4 * n + (i & 3); }
struct Unit { int pm, pn; };
struct Gemm { const bf16_t* A; const bf16_t* Bt; int M, N, K; };
struct StaticOrder {
    int nM, nN, nwg, G, c;
    DI void init(int M, int N, int G_, int c_) { nM = M / BM; nN = N / BM; nwg = nM * nN; G = G_; c = c_; }
    DI bool next(int i, Unit& u) const {
        const long L = (long)i * G + c; if (L >= nwg) return false;
        int wgid = (int)L; { const int q = nwg / NXCD, r = nwg % NXCD, xcd = wgid % NXCD, off = wgid / NXCD; wgid = (xcd < r ? xcd * (q + 1) : r * (q + 1) + (xcd - r) * q) + off; }
        const int nig = WGM * nN, gid = wgid / nig, fm = gid * WGM, gsz = (nM - fm) < WGM ? (nM - fm) : WGM;
        u.pm = fm + ((wgid % nig) % gsz); u.pn = (wgid % nig) / gsz; return true;
    }
};

template <class Epi>
DI void gemm_phase(LAS unsigned char* lds, const Gemm g, const StaticOrder& S, const Epi& E, const int tid) {
    const int wid = __builtin_amdgcn_readfirstlane(tid >> 6), lane = tid & 63, wr = wid >> 2, wc = wid & 3, fr = lane & 15, fq = lane >> 4;
    const int K = g.K, nt = K / BK;
    unsigned voffA[2], voffB[2];
#pragma unroll
    for (int i = 0; i < 2; ++i) { int R, C; stage_rc(tid * 16 + i * 8192, R, C); const int Rb = Epi::PERM ? ((R & ~31) + perm32(R & 31)) : R;
        voffA[i] = (unsigned)(R * K + C) * 2u; voffB[i] = (unsigned)(Rb * K + C) * 2u; }
    const size_t kstep = (size_t)(BK * 2);
    const size_t hstep = (size_t)HALF * K * 2;
    const size_t tstep = 2 * hstep;
    const unsigned ldsw = (unsigned)wid * 1024u;
    const int aoff = lds_byte(wr * 64 + fr, fq * 8), boff = lds_byte(wc * 32 + fr, fq * 8);
#define PG8_SA(b, h) (((b) * 2 + (h)) * HTB)
#define PG8_SB(b, h) ((4 + (b) * 2 + (h)) * HTB)
#define PG8_STAGE(bufoff, gbase, voff) do { _Pragma("unroll") for (int _i = 0; _i < 2; ++_i) \
        __builtin_amdgcn_global_load_lds((const unsigned*)((const char*)(gbase) + (voff)[_i]), (LAS unsigned*)(lds + (bufoff) + ldsw + _i * 8192), 16, 0, 0); } while (0)
#define PG8_LDA(dst, b, h) do { _Pragma("unroll") for (int m = 0; m < 4; ++m) _Pragma("unroll") for (int k = 0; k < 2; ++k) dst[m][k] = *(const LAS bf16x8*)(lds + PG8_SA(b, h) + aoff + m * 2048 + k * 1024); } while (0)
#define PG8_LDB(dst, b, h) do { _Pragma("unroll") for (int n = 0; n < 2; ++n) _Pragma("unroll") for (int k = 0; k < 2; ++k) dst[n][k] = *(const LAS bf16x8*)(lds + PG8_SB(b, h) + boff + n * 2048 + k * 1024); } while (0)
#define PG8_MMA(ai, bj, At, Bt) do { __builtin_amdgcn_s_setprio(1); _Pragma("unroll") for (int m = 0; m < 4; ++m) _Pragma("unroll") for (int n = 0; n < 2; ++n) _Pragma("unroll") for (int k = 0; k < 2; ++k) \
        acc[ai][bj][m][n] = __builtin_amdgcn_mfma_f32_16x16x32_bf16(Bt[n][k], At[m][k], acc[ai][bj][m][n], 0, 0, 0); __builtin_amdgcn_s_setprio(0); } while (0)
#define PG8_WAIT_V(n) asm volatile("s_waitcnt vmcnt(" #n ")" ::: "memory")
#define PG8_WAIT_L(n) asm volatile("s_waitcnt lgkmcnt(" #n ")" ::: "memory")
#define PG8_BAR __builtin_amdgcn_s_barrier()
#define PG8_SCHED __builtin_amdgcn_sched_barrier(0)
    Unit cur, nxt; int ui = 0;
    if (!S.next(0, cur)) return;
    f32x4 acc[2][2][4][2];
#pragma unroll
    for (int a = 0; a < 2; ++a)
#pragma unroll
        for (int b = 0; b < 2; ++b)
#pragma unroll
            for (int m = 0; m < 4; ++m)
#pragma unroll
                for (int n = 0; n < 2; ++n) acc[a][b][m][n] = (f32x4){0.f, 0.f, 0.f, 0.f};
    bf16x8 At[4][2], B0[2][2], B1[2][2];
    const char* cA = (const char*)g.A + (size_t)cur.pm * tstep; const char* cB = (const char*)g.Bt + (size_t)cur.pn * tstep;
    PG8_STAGE(PG8_SB(0, 0), cB, voffB); PG8_STAGE(PG8_SA(0, 0), cA, voffA); PG8_STAGE(PG8_SB(0, 1), cB + hstep, voffB); PG8_STAGE(PG8_SA(0, 1), cA + hstep, voffA);
    if (wr == 1) PG8_BAR;
    PG8_WAIT_V(4); PG8_BAR;
    PG8_STAGE(PG8_SB(1, 0), cB + kstep, voffB); PG8_STAGE(PG8_SA(1, 0), cA + kstep, voffA); PG8_STAGE(PG8_SB(1, 1), cB + hstep + kstep, voffB);
    PG8_WAIT_V(6); PG8_BAR;
    for (;;) {
        const bool has_next = S.next(ui + 1, nxt);
        const char* nA = has_next ? (const char*)g.A + (size_t)nxt.pm * tstep : cA; const char* nB = has_next ? (const char*)g.Bt + (size_t)nxt.pn * tstep : cB;
        for (int t = 0; t < nt; t += 2) {
            const bool last = (t == nt - 2);
            const char* a1 = cA + (size_t)(t + 1) * kstep;
            const char* a2 = last ? nA : cA + (size_t)(t + 2) * kstep; const char* b2 = last ? nB : cB + (size_t)(t + 2) * kstep;
            const char* a3 = a2 + kstep; const char* b3 = b2 + kstep;
            PG8_LDB(B0, 0, 0); PG8_SCHED; PG8_LDA(At, 0, 0); PG8_STAGE(PG8_SA(1, 1), a1 + hstep, voffA);
            PG8_WAIT_L(8); PG8_BAR; PG8_WAIT_L(0); PG8_MMA(0, 0, At, B0); PG8_BAR; PG8_SCHED;
            PG8_LDB(B1, 0, 1); PG8_STAGE(PG8_SB(0, 0), b2, voffB);
            PG8_BAR; PG8_WAIT_L(0); PG8_MMA(0, 1, At, B1); PG8_BAR;
            PG8_LDA(At, 0, 1); PG8_STAGE(PG8_SA(0, 0), a2, voffA);
            PG8_BAR; PG8_WAIT_L(0); PG8_MMA(1, 0, At, B0); PG8_BAR; PG8_SCHED;
            PG8_STAGE(PG8_SB(0, 1), b2 + hstep, voffB);
            PG8_WAIT_V(6); PG8_BAR; PG8_MMA(1, 1, At, B1); PG8_BAR;
            PG8_LDB(B0, 1, 0); PG8_SCHED; PG8_LDA(At, 1, 0); PG8_STAGE(PG8_SA(0, 1), a2 + hstep, voffA);
            PG8_WAIT_L(8); PG8_BAR; PG8_WAIT_L(0); PG8_MMA(0, 0, At, B0); PG8_BAR; PG8_SCHED;
            PG8_LDB(B1, 1, 1); PG8_STAGE(PG8_SB(1, 0), b3, voffB);
            PG8_BAR; PG8_WAIT_L(0); PG8_MMA(0, 1, At, B1); PG8_BAR;
            PG8_LDA(At, 1, 1); PG8_STAGE(PG8_SA(1, 0), a3, voffA);
            PG8_BAR; PG8_WAIT_L(0); PG8_MMA(1, 0, At, B0); PG8_BAR; PG8_SCHED;
            PG8_STAGE(PG8_SB(1, 1), b3 + hstep, voffB);
            PG8_WAIT_V(6); PG8_BAR; PG8_MMA(1, 1, At, B1); PG8_BAR;
        }
        { int fr2 = fr, fq2 = fq; asm volatile("" : "+v"(fr2), "+v"(fq2)); E(acc, cur, wr, wc, fr2, fq2); }
        if (!has_next) break;
#pragma unroll
        for (int a = 0; a < 2; ++a)
#pragma unroll
            for (int b = 0; b < 2; ++b)
#pragma unroll
                for (int m = 0; m < 4; ++m)
#pragma unroll
                    for (int n = 0; n < 2; ++n) acc[a][b][m][n] = (f32x4){0.f, 0.f, 0.f, 0.f};
        cur = nxt; cA = nA; cB = nB; ++ui;
    }
    PG8_WAIT_V(0);
    if (wr == 0) PG8_BAR;
    PG8_BAR;
#undef PG8_SA
#undef PG8_SB
#undef PG8_STAGE
#undef PG8_LDA
#undef PG8_LDB
#undef PG8_MMA
#undef PG8_WAIT_V
#undef PG8_WAIT_L
#undef PG8_BAR
#undef PG8_SCHED
}
}

typedef f32x4 AccT[2][2][4][2];
DI u32x4 pack8(f32x4 a, f32x4 b) { u32x4 w; w.x = pk2(a[0], a[1]); w.y = pk2(a[2], a[3]); w.z = pk2(b[0], b[1]); w.w = pk2(b[2], b[3]); return w; }
DI size_t fragoff(int row, int kidx, int KS) { return (size_t)((((row >> 5) * KS + (kidx >> 4)) * 64 + (row & 31) + 32 * ((kidx >> 3) & 1)) * 8); }

DI void kt_store(unsigned char* sc, const u32x4 w, int fr, int fq, bf16_t* ktbase, int dbase, int sbase) {
    unsigned short* s16 = (unsigned short*)sc;
#pragma unroll
    for (int j = 0; j < 8; ++j) s16[(8 * fq + j) * 24 + fr] = (unsigned short)((w[j >> 1] >> (16 * (j & 1))) & 0xffffu);
    asm volatile("s_waitcnt lgkmcnt(0)" ::: "memory");
    const int L = fr + 16 * fq, fl = L >> 1, th = L & 1;
    const u32x4 r = *(const u32x4*)(sc + (fl * 24 + th * 8) * 2);
    asm volatile("s_waitcnt lgkmcnt(0)" ::: "memory");
    *(u32x4*)(ktbase + fragoff(dbase + fl, sbase + th * 8, 8)) = r;
}
struct EpiInN {
    static constexpr bool PERM = true;
    const Params* p; int S; unsigned char* smem;
    DI void operator()(const AccT& acc, const pg8::Unit& u, int wr, int wc, int fr, int fq) const {
        const int pn = u.pn;
        const int d0 = wc * 32 + 8 * fq;
        if (pn < 8) {
            bf16_t* dst = pn < 4 ? p->Qb : p->Kb; const int head = pn & 3;
#pragma unroll
            for (int ai = 0; ai < 2; ++ai)
#pragma unroll
                for (int m = 0; m < 4; ++m) {
                    const int row = u.pm * 256 + ai * 128 + wr * 64 + m * 16 + fr; const int pos = row % S; const int chunk = row >> 7, t = row & 127;
                    const f32x4 c0 = *(const f32x4*)(p->cosT + pos * 128 + d0), c1 = *(const f32x4*)(p->cosT + pos * 128 + d0 + 4);
                    const f32x4 s0 = *(const f32x4*)(p->sinT + pos * 128 + d0), s1 = *(const f32x4*)(p->sinT + pos * 128 + d0 + 4);
                    const f32x4 x10 = acc[ai][0][m][0], x11 = acc[ai][0][m][1], x20 = acc[ai][1][m][0], x21 = acc[ai][1][m][1];
                    const f32x4 o10 = x10 * c0 - x20 * s0, o11 = x11 * c1 - x21 * s1, o20 = x10 * s0 + x20 * c0, o21 = x11 * s1 + x21 * c1;
                    bf16_t* base = dst + (size_t)(chunk * 4 + head) * (128 * 256);
                    const u32x4 w1 = pack8(o10, o11), w2 = pack8(o20, o21);
                    *(u32x4*)(base + fragoff(t, d0, 16)) = w1;
                    *(u32x4*)(base + fragoff(t, d0 + 128, 16)) = w2;
                    if (pn >= 4) {
                        unsigned char* sc = smem + 131072 + (wr * 4 + wc) * 2048;
                        bf16_t* ktb = p->KbT + (size_t)(chunk * 4 + head) * (256 * 128);
                        kt_store(sc, w1, fr, fq, ktb, wc * 32, wr * 64 + m * 16);
                        kt_store(sc, w2, fr, fq, ktb, 128 + wc * 32, wr * 64 + m * 16);
                    }
                }
        } else if (pn < 12) {
            bf16_t* dst = pn < 10 ? p->Qa : p->Ka;
#pragma unroll
            for (int ai = 0; ai < 2; ++ai)
#pragma unroll
                for (int m = 0; m < 4; ++m) {
                    const int row = u.pm * 256 + ai * 128 + wr * 64 + m * 16 + fr; const int chunk = row >> 7, t = row & 127;
#pragma unroll
                    for (int bj = 0; bj < 2; ++bj) {
                        const int head = ((pn - 8) & 1) * 2 + bj;
                        bf16_t* base = dst + (size_t)(chunk * 4 + head) * (128 * 128);
                        const u32x4 w1 = pack8(acc[ai][bj][m][0], acc[ai][bj][m][1]);
                        *(u32x4*)(base + fragoff(t, d0, 8)) = w1;
                        if (pn >= 10) kt_store(smem + 131072 + (wr * 4 + wc) * 2048, w1, fr, fq, p->KaT + (size_t)(chunk * 4 + head) * (128 * 128), wc * 32, wr * 64 + m * 16);
                    }
                }
        } else {
#pragma unroll
            for (int ai = 0; ai < 2; ++ai)
#pragma unroll
                for (int m = 0; m < 4; ++m) {
                    const int row = u.pm * 256 + ai * 128 + wr * 64 + m * 16 + fr;
                    bf16_t* rp = p->E + (size_t)row * 4096 + (pn - 12) * 256 + d0;
#pragma unroll
                    for (int bj = 0; bj < 2; ++bj) *(u32x4*)(rp + bj * 128) = pack8(acc[ai][bj][m][0], acc[ai][bj][m][1]);
                }
        }
    }
};
struct EpiInT {
    static constexpr bool PERM = true;
    const Params* p; int S;
    DI void operator()(const AccT& acc, const pg8::Unit& u, int wr, int wc, int fr, int fq) const {
        const int pm = u.pm;
        const int s0 = wc * 32 + 8 * fq;
        bf16_t* dst = pm < 4 ? p->VaT : p->VbT; const int head = pm & 3;
#pragma unroll
        for (int ai = 0; ai < 2; ++ai)
#pragma unroll
            for (int bj = 0; bj < 2; ++bj) {
                const int chunk = u.pn * 2 + bj;
                bf16_t* base = dst + (size_t)(chunk * 4 + head) * (256 * 128);
#pragma unroll
                for (int m = 0; m < 4; ++m) { const int v = ai * 128 + wr * 64 + m * 16 + fr; *(u32x4*)(base + fragoff(v, s0, 8)) = pack8(acc[ai][bj][m][0], acc[ai][bj][m][1]); }
            }
    }
};
template <bool XB> struct EpiRes {
    static constexpr bool PERM = false;
    float* Y;
    const bf16_t* X;
    DI void operator()(const AccT& acc, const pg8::Unit& u, int wr, int wc, int fr, int fq) const {
        const int row0 = u.pm * 256 + wr * 64 + fr, col0 = u.pn * 256 + wc * 32 + 4 * fq;
#pragma unroll
        for (int ai = 0; ai < 2; ++ai) {
            f32x4 xv[4][2][2];
#pragma unroll
            for (int m = 0; m < 4; ++m)
#pragma unroll
                for (int bj = 0; bj < 2; ++bj)
#pragma unroll
                    for (int n = 0; n < 2; ++n) {
                        const size_t off = (size_t)(row0 + ai * 128 + m * 16) * DM + col0 + bj * 128 + n * 16;
                        if (XB) { const u32x2 xw = *(const u32x2*)(X + off); xv[m][bj][n] = (f32x4){bflo(xw.x), bfhi(xw.x), bflo(xw.y), bfhi(xw.y)}; }
                        else xv[m][bj][n] = *(const f32x4*)(Y + off);
                    }
#pragma unroll
            for (int m = 0; m < 4; ++m)
#pragma unroll
                for (int bj = 0; bj < 2; ++bj)
#pragma unroll
                    for (int n = 0; n < 2; ++n) {
                        const size_t off = (size_t)(row0 + ai * 128 + m * 16) * DM + col0 + bj * 128 + n * 16;
                        *(f32x4*)(Y + off) = xv[m][bj][n] * ALPHA + acc[ai][bj][m][n];
                    }
        }
    }
};
struct EpiB16 {
    static constexpr bool PERM = true;
    bf16_t* O; int ldc;
    DI void operator()(const AccT& acc, const pg8::Unit& u, int wr, int wc, int fr, int fq) const {
        const int row0 = u.pm * 256 + wr * 64 + fr, col0 = u.pn * 256 + wc * 32 + 8 * fq;
#pragma unroll
        for (int ai = 0; ai < 2; ++ai)
#pragma unroll
            for (int m = 0; m < 4; ++m) { bf16_t* rp = O + (size_t)(row0 + ai * 128 + m * 16) * ldc + col0;
#pragma unroll
                for (int bj = 0; bj < 2; ++bj) *(u32x4*)(rp + bj * 128) = pack8(acc[ai][bj][m][0], acc[ai][bj][m][1]); }
    }
};

DI void transpose_cvt(const float* W, bf16_t* WT, int K, int N, int tid) {
    const long total = (long)N * (K / 8);
    for (long i = (long)blockIdx.x * 512 + tid; i < total; i += (long)gridDim.x * 512) {
        const int n = (int)(i % N), kc = (int)(i / N);
        const float* w = W + (size_t)(kc * 8) * N + n;
        float v[8];
#pragma unroll
        for (int j = 0; j < 8; ++j) v[j] = w[(size_t)j * N];
        u32x4 o; o.x = pk2(v[0], v[1]); o.y = pk2(v[2], v[3]); o.z = pk2(v[4], v[5]); o.w = pk2(v[6], v[7]);
        *(u32x4*)(WT + (size_t)n * K + kc * 8) = o;
    }
}
DI void phase_prep(const Params& p, int tid) {
    const long gtid = (long)blockIdx.x * 512 + tid, gsz = (long)gridDim.x * 512;
    for (long i = gtid; i < 2L * NW * 128; i += gsz) {
        const int n = (int)(i % NW), kc = (int)((i / NW) % 128), l = (int)(i / ((long)NW * 128));
        int src; float sc = 1.f;
        if (n < NNORM) {
            if (n < 1024) src = 3088 + n;
            else if (n < 2048) { src = 4112 + (n - 1024); sc = 0.0625f; }
            else if (n < 2560) { src = n - 2048; sc = 0.08838834764831845f; }
            else if (n < 3072) src = 512 + (n - 2560);
            else if (n < 4096) src = 2048 + (n - 3072);
            else if (n < 5120) src = 6160 + (n - 4096);
            else if (n < 6144) src = 7184 + (n - 5120);
            else src = 8208 + (n - 6144);
        } else {
            const int m = n - NNORM;
            if (m < 1024) src = 1024 + m;
            else src = 5136 + (m - 1024);
        }
        const float* w = p.w_in + (size_t)l * DM * NIN + (size_t)(kc * 8) * NIN + src;
        float v[8];
#pragma unroll
        for (int j = 0; j < 8; ++j) v[j] = w[(size_t)j * NIN] * sc;
        u32x4 o; o.x = pk2(v[0], v[1]); o.y = pk2(v[2], v[3]); o.z = pk2(v[4], v[5]); o.w = pk2(v[6], v[7]);
        *(u32x4*)(p.WinT + ((size_t)l * NW + n) * DM + kc * 8) = o;
    }
    for (int l = 0; l < 2; ++l) {
        transpose_cvt(p.w_o + (size_t)l * DM * DM, p.WoT + (size_t)l * DM * DM, DM, DM, tid);
        transpose_cvt(p.w_up + (size_t)l * DM * NUP, p.WupT + (size_t)l * NUP * DM, DM, NUP, tid);
        transpose_cvt(p.w_down + (size_t)l * DFF * DM, p.WdT + (size_t)l * DM * DFF, DFF, DM, tid);
    }
    for (long i = gtid; i < 2L * 16 * 1024; i += gsz) {
        const int k = (int)(i & 1023), gi = (int)((i >> 10) & 15), l = (int)(i >> 14);
        p.WgT[i] = (bf16_t)f2bf(p.w_in[(size_t)l * DM * NIN + (size_t)k * NIN + 3072 + gi]);
    }
    for (long i = gtid; i < 4096L * 128; i += gsz) {
        const int pos = (int)(i >> 7), j = (int)(i & 127);
        const double inv = pow(10000.0, -(double)j / 128.0);
        const double ang = (double)pos * inv;
        const float c = (float)cos(ang), s = (float)sin(ang);
        p.cosT[i] = c; p.sinT[i] = s;
    }
}

DI void phase_ln(const void* srcv, const int srcmode, const bf16_t* xres,
                 const float* g, const float* b, float* dstf, bf16_t* dstb, int ntok, int tid,
                 unsigned char* smem, const float* wg, const float* bias16, float* gpre) {
    (void)smem; (void)wg; (void)bias16; (void)gpre;
    const int wid = tid >> 6, lane = tid & 63;
    const int rstride = gridDim.x * 8;
    f32x4 gvv[2][2], bvv[2][2];
#pragma unroll
    for (int q = 0; q < 2; ++q)
#pragma unroll
        for (int h = 0; h < 2; ++h) { gvv[q][h] = *(const f32x4*)(g + q * 512 + lane * 8 + h * 4); bvv[q][h] = *(const f32x4*)(b + q * 512 + lane * 8 + h * 4); }
    u32x4 na[2], nb[2];
#define LN_LOAD(r_) do { _Pragma("unroll") for (int q = 0; q < 2; ++q) { \
        if (srcmode) { na[q] = *(const u32x4*)((const bf16_t*)srcv + (size_t)(r_) * DM + q * 512 + lane * 8); nb[q] = *(const u32x4*)(xres + (size_t)(r_) * DM + q * 512 + lane * 8); } \
        else { na[q] = *(const u32x4*)((const float*)srcv + (size_t)(r_) * DM + q * 512 + lane * 8); nb[q] = *(const u32x4*)((const float*)srcv + (size_t)(r_) * DM + q * 512 + lane * 8 + 4); } } } while (0)
    {
        const int r0 = blockIdx.x * 8 + wid;
        if (r0 < ntok) LN_LOAD(r0);
    }
    for (int row = blockIdx.x * 8 + wid; row < ntok; row += rstride) {
        f32x4 v[2][2]; float s = 0.f;
#pragma unroll
        for (int q = 0; q < 2; ++q) {
            const u32x4 ra = na[q], rb = nb[q];
            if (srcmode) {
                v[q][0] = (f32x4){bflo(ra.x) + ALPHA * bflo(rb.x), bfhi(ra.x) + ALPHA * bfhi(rb.x), bflo(ra.y) + ALPHA * bflo(rb.y), bfhi(ra.y) + ALPHA * bfhi(rb.y)};
                v[q][1] = (f32x4){bflo(ra.z) + ALPHA * bflo(rb.z), bfhi(ra.z) + ALPHA * bfhi(rb.z), bflo(ra.w) + ALPHA * bflo(rb.w), bfhi(ra.w) + ALPHA * bfhi(rb.w)};
            } else { v[q][0] = __builtin_bit_cast(f32x4, ra); v[q][1] = __builtin_bit_cast(f32x4, rb); }
#pragma unroll
            for (int h = 0; h < 2; ++h) s += v[q][h][0] + v[q][h][1] + v[q][h][2] + v[q][h][3];
        }
        if (row + rstride < ntok) LN_LOAD(row + rstride);
#pragma unroll
        for (int o = 32; o >= 1; o >>= 1) s += __shfl_xor(s, o);
        const float mu = s * (1.f / 1024.f);
        float ss = 0.f;
#pragma unroll
        for (int q = 0; q < 2; ++q)
#pragma unroll
            for (int h = 0; h < 2; ++h) { v[q][h] = v[q][h] - mu; ss += v[q][h][0] * v[q][h][0] + v[q][h][1] * v[q][h][1] + v[q][h][2] * v[q][h][2] + v[q][h][3] * v[q][h][3]; }
#pragma unroll
        for (int o = 32; o >= 1; o >>= 1) ss += __shfl_xor(ss, o);
        const float rstd = rsqrtf(ss * (1.f / 1024.f) + LN_EPS);
#pragma unroll
        for (int q = 0; q < 2; ++q) {
            const f32x4 y0 = v[q][0] * rstd * gvv[q][0] + bvv[q][0], y1 = v[q][1] * rstd * gvv[q][1] + bvv[q][1];
            if (dstf) { *(f32x4*)(dstf + (size_t)row * DM + q * 512 + lane * 8) = y0; *(f32x4*)(dstf + (size_t)row * DM + q * 512 + lane * 8 + 4) = y1; }
            if (dstb) *(u32x4*)(dstb + (size_t)row * DM + q * 512 + lane * 8) = pack8(y0, y1);
        }
    }
#undef LN_LOAD
}

DI void phase_gscan(const Params& p, const float* gpre, int nchunks, int tid) {
    const int wid = tid >> 6, lane = tid & 63;
    const int tstride = gridDim.x * 8, ntask = nchunks * 8;
    float ni0 = 0.f, nf0 = 0.f, ni1 = 0.f, nf1 = 0.f;
#define GS_LOAD(task_) do { const int ch_ = (task_) >> 3, dir_ = ((task_) >> 2) & 1, head_ = (task_) & 3; \
        const int q0_ = dir_ ? 127 - 2 * lane : 2 * lane, q1_ = dir_ ? 126 - 2 * lane : 2 * lane + 1; \
        const float* r0_ = gpre + (size_t)(ch_ * 128 + q0_) * 16 + dir_ * 8 + head_; const float* r1_ = gpre + (size_t)(ch_ * 128 + q1_) * 16 + dir_ * 8 + head_; \
        ni0 = r0_[0]; nf0 = r0_[4]; ni1 = r1_[0]; nf1 = r1_[4]; } while (0)
    { const int t0 = blockIdx.x * 8 + wid; if (t0 < ntask) GS_LOAD(t0); }
    for (int task = blockIdx.x * 8 + wid; task < ntask; task += tstride) {
        const int ch = task >> 3, dir = (task >> 2) & 1, head = task & 3;
        const int p0 = dir ? 127 - 2 * lane : 2 * lane, p1 = dir ? 126 - 2 * lane : 2 * lane + 1;
        const float i0 = ni0, f0 = nf0, i1 = ni1, f1 = nf1;
        if (task + tstride < ntask) GS_LOAD(task + tstride);
        const float l0 = fminf(f0, 0.f) - log1pf(__expf(-fabsf(f0))), l1 = fminf(f1, 0.f) - log1pf(__expf(-fabsf(f1)));
        const float pair = l0 + l1;
        float inc = pair;
#pragma unroll
        for (int d = 1; d < 64; d <<= 1) { const float t = __shfl_up(inc, d); if (lane >= d) inc += t; }
        const float exc = inc - pair;
        const float c0 = exc + l0, c1 = exc + pair;
        const float b0 = i0 - c0, b1 = i1 - c1;
        float mx = fmaxf(b0, b1);
#pragma unroll
        for (int d = 1; d < 64; d <<= 1) { const float t = __shfl_up(mx, d); if (lane >= d) mx = fmaxf(mx, t); }
        float mexc = __shfl_up(mx, 1); if (lane == 0) mexc = -3.0e38f;
        const float pm0 = fmaxf(mexc, b0), pm1 = fmaxf(pm0, b1);
        float* gp = p.gates + ((size_t)(ch * 2 + dir) * 4 + head) * 384;
        gp[p0] = b0; gp[128 + p0] = pm0; gp[256 + p0] = c0;
        gp[p1] = b1; gp[128 + p1] = pm1; gp[256 + p1] = c1;
    }
#undef GS_LOAD
}

DI void phase_gates2(const Params& p, unsigned char* smem, int layer, const bf16_t* xin, int nchunks, int tid) {
    const int wid = tid >> 6, lane = tid & 63, r16 = lane & 15, kq = lane >> 4;
    float* pre = (float*)smem;
    const bf16_t* wgt = p.WgT + (size_t)layer * 16 * DM;
    for (int ch = blockIdx.x; ch < nchunks; ch += gridDim.x) {
        {
            const bf16_t* ap = xin + (size_t)(ch * 128 + wid * 16 + r16) * DM + kq * 8;
            const bf16_t* bp = wgt + (size_t)r16 * DM + kq * 8;
            f32x4 acc = {0.f, 0.f, 0.f, 0.f};
#pragma unroll 8
            for (int ks = 0; ks < 32; ++ks) {
                const bf16x8 av = *(const bf16x8*)(ap + ks * 32), bv = *(const bf16x8*)(bp + ks * 32);
                acc = __builtin_amdgcn_mfma_f32_16x16x32_bf16(av, bv, acc, 0, 0, 0);
            }
            const float bb = p.b_if[layer * 16 + r16];
#pragma unroll
            for (int r = 0; r < 4; ++r) pre[(wid * 16 + kq * 4 + r) * 17 + r16] = acc[r] + bb;
        }
        __syncthreads();
        {
            const int dir = wid >> 2, head = wid & 3;
            const int p0 = dir ? 127 - 2 * lane : 2 * lane, p1 = dir ? 126 - 2 * lane : 2 * lane + 1;
            const float i0 = pre[p0 * 17 + dir * 8 + head], f0 = pre[p0 * 17 + dir * 8 + 4 + head];
            const float i1 = pre[p1 * 17 + dir * 8 + head], f1 = pre[p1 * 17 + dir * 8 + 4 + head];
            const float l0 = fminf(f0, 0.f) - log1pf(__expf(-fabsf(f0))), l1 = fminf(f1, 0.f) - log1pf(__expf(-fabsf(f1)));
            const float pair = l0 + l1;
            float inc = pair;
#pragma unroll
            for (int d = 1; d < 64; d <<= 1) { const float t = __shfl_up(inc, d); if (lane >= d) inc += t; }
            const float exc = inc - pair;
            const float c0 = exc + l0, c1 = exc + pair;
            const float b0 = i0 - c0, b1 = i1 - c1;
            float mx = fmaxf(b0, b1);
#pragma unroll
            for (int d = 1; d < 64; d <<= 1) { const float t = __shfl_up(mx, d); if (lane >= d) mx = fmaxf(mx, t); }
            float mexc = __shfl_up(mx, 1); if (lane == 0) mexc = -3.0e38f;
            const float pm0 = fmaxf(mexc, b0), pm1 = fmaxf(pm0, b1);
            float* gp = p.gates + ((size_t)(ch * 2 + dir) * 4 + head) * 384;
            gp[p0] = b0; gp[128 + p0] = pm0; gp[256 + p0] = c0;
            gp[p1] = b1; gp[128 + p1] = pm1; gp[256 + p1] = c1;
        }
        __syncthreads();
    }
}

DI void phase_merge(const Params& p, int layer, int ntok, int tid) {
    const int wid = tid >> 6, lane = tid & 63;
    const int ch0 = lane * 16;
    const int rstride = gridDim.x * 8;
    float gav[16], gbv[16];
#pragma unroll
    for (int j = 0; j < 16; j += 4) {
        const f32x4 t0 = *(const f32x4*)(p.g_a + layer * DM + ch0 + j), t1 = *(const f32x4*)(p.g_b + layer * DM + ch0 + j);
#pragma unroll
        for (int k = 0; k < 4; ++k) { gav[j + k] = t0[k]; gbv[j + k] = t1[k]; }
    }
    u32x4 pre[8][2];
#define MERGE_LOAD(r) do { \
        const u32x4* a0 = (const u32x4*)(p.H0 + (size_t)(r) * DM + ch0); const u32x4* a1 = (const u32x4*)(p.H1 + (size_t)(r) * DM + ch0); \
        const u32x4* b0 = (const u32x4*)(p.H2 + (size_t)(r) * DM + ch0); const u32x4* b1 = (const u32x4*)(p.H3 + (size_t)(r) * DM + ch0); \
        const u32x4* e = (const u32x4*)(p.E + (size_t)(r) * 4096 + ch0); \
        _Pragma("unroll") for (int q = 0; q < 2; ++q) { pre[0][q] = a0[q]; pre[1][q] = a1[q]; pre[2][q] = b0[q]; pre[3][q] = b1[q]; pre[4][q] = e[q]; pre[5][q] = e[128 + q]; pre[6][q] = e[256 + q]; pre[7][q] = e[384 + q]; } } while (0)
    { const int r0 = blockIdx.x * 8 + wid; if (r0 < ntok) MERGE_LOAD(r0); }
    for (int row = blockIdx.x * 8 + wid; row < ntok; row += rstride) {
        float ha[16], hb[16], oa[16], gb[16], ma[16], mb[16];
        {
            u32x4 cur[8][2];
#pragma unroll
            for (int i = 0; i < 8; ++i) { cur[i][0] = pre[i][0]; cur[i][1] = pre[i][1]; }
            if (row + rstride < ntok) MERGE_LOAD(row + rstride);
#pragma unroll
            for (int q = 0; q < 2; ++q) {
                const u32x4 x0 = cur[0][q], x1 = cur[1][q], y0 = cur[2][q], y1 = cur[3][q], eo = cur[4][q], eg = cur[5][q], em = cur[6][q], en = cur[7][q];
#pragma unroll
                for (int j = 0; j < 4; ++j) {
                    ha[q * 8 + 2 * j] = bflo(x0[j]) + bflo(x1[j]); ha[q * 8 + 2 * j + 1] = bfhi(x0[j]) + bfhi(x1[j]);
                    hb[q * 8 + 2 * j] = bflo(y0[j]) + bflo(y1[j]); hb[q * 8 + 2 * j + 1] = bfhi(y0[j]) + bfhi(y1[j]);
                    oa[q * 8 + 2 * j] = bflo(eo[j]); oa[q * 8 + 2 * j + 1] = bfhi(eo[j]);
                    gb[q * 8 + 2 * j] = bflo(eg[j]); gb[q * 8 + 2 * j + 1] = bfhi(eg[j]);
                    ma[q * 8 + 2 * j] = bflo(em[j]); ma[q * 8 + 2 * j + 1] = bfhi(em[j]);
                    mb[q * 8 + 2 * j] = bflo(en[j]); mb[q * 8 + 2 * j + 1] = bfhi(en[j]);
                }
            }
        }
        float sa = 0.f, sb = 0.f;
#pragma unroll
        for (int j = 0; j < 16; ++j) { ha[j] *= sigmoidf_(oa[j]); sa += ha[j]; sb += hb[j]; }
#pragma unroll
        for (int o = 8; o >= 1; o >>= 1) { sa += __shfl_xor(sa, o); sb += __shfl_xor(sb, o); }
        const float mua = sa * (1.f / 256.f), mub = sb * (1.f / 256.f);
        float va = 0.f, vb = 0.f;
#pragma unroll
        for (int j = 0; j < 16; ++j) { ha[j] -= mua; hb[j] -= mub; va += ha[j] * ha[j]; vb += hb[j] * hb[j]; }
#pragma unroll
        for (int o = 8; o >= 1; o >>= 1) { va += __shfl_xor(va, o); vb += __shfl_xor(vb, o); }
        const float ra = rsqrtf(va * (1.f / 256.f) + LN_EPS), rb = rsqrtf(vb * (1.f / 256.f) + LN_EPS);
        unsigned ow[8];
#pragma unroll
        for (int j = 0; j < 16; j += 2) {
            float r[2];
#pragma unroll
            for (int k = 0; k < 2; ++k) {
                const float ya = ha[j + k] * ra * gav[j + k];
                const float yb = hb[j + k] * rb * gbv[j + k] * (gb[j + k] * sigmoidf_(gb[j + k]));
                r[k] = sigmoidf_(ma[j + k]) * ya + sigmoidf_(mb[j + k]) * yb;
            }
            ow[j >> 1] = pk2(r[0], r[1]);
        }
        u32x4* op = (u32x4*)(p.merged + (size_t)row * DM + ch0);
        op[0] = (u32x4){ow[0], ow[1], ow[2], ow[3]}; op[1] = (u32x4){ow[4], ow[5], ow[6], ow[7]};
    }
}

DI float gelu_tanh(float x) {
    const float u = 0.7978845608028654f * (x + 0.044715f * x * x * x);
    const float e = __expf(2.f * u);
    const float th = 1.f - 2.f * frcp(e + 1.f);
    return 0.5f * x * (1.f + th);
}
DI void phase_conv(const Params& p, int layer, int ntok, int S, int tid) {
    const float* cw = p.conv_w + (size_t)layer * 3 * NUP; const float* cbias = p.conv_b + (size_t)layer * NUP;
    const int wid = tid >> 6, lane = tid & 63;
    constexpr int SEG = 16, NCW = 11;
    const int ntask = NCW * (ntok / SEG);
    for (int task = blockIdx.x * 8 + wid; task < ntask; task += gridDim.x * 8) {
        const int cwv = task % NCW, seg = task / NCW;
        const int c = (cwv * 64 + lane) * 4;
        const int t0 = seg * SEG, pos0 = t0 % S;
        const f32x4 wv0 = *(const f32x4*)(cw + c), wv1 = *(const f32x4*)(cw + NUP + c), wv2 = *(const f32x4*)(cw + 2 * NUP + c), bv = *(const f32x4*)(cbias + c);
        const f32x4 wg0 = *(const f32x4*)(cw + DFF + c), wg1 = *(const f32x4*)(cw + NUP + DFF + c), wg2 = *(const f32x4*)(cw + 2 * NUP + DFF + c), bg = *(const f32x4*)(cbias + DFF + c);
        const bf16_t* hv = p.hu + (size_t)t0 * NUP + c; const bf16_t* hg = hv + DFF;
        bf16_t* op = p.ff + (size_t)t0 * DFF + c;
        const u32x2 z = {0u, 0u};
        u32x2 rv[SEG + 2], rg[SEG + 2];
        rv[0] = pos0 > 0 ? *(const u32x2*)(hv - NUP) : z; rg[0] = pos0 > 0 ? *(const u32x2*)(hg - NUP) : z;
#pragma unroll
        for (int i = 0; i < SEG; ++i) { rv[i + 1] = *(const u32x2*)(hv + (size_t)i * NUP); rg[i + 1] = *(const u32x2*)(hg + (size_t)i * NUP); }
        { const bool hn = (pos0 + SEG - 1) < S - 1; rv[SEG + 1] = hn ? *(const u32x2*)(hv + (size_t)SEG * NUP) : z; rg[SEG + 1] = hn ? *(const u32x2*)(hg + (size_t)SEG * NUP) : z; }
#pragma unroll
        for (int i = 0; i < SEG; ++i) {
            const u32x2 pv = rv[i], cv = rv[i + 1], nv = rv[i + 2], pg = rg[i], cg = rg[i + 1], ng = rg[i + 2];
            const f32x4 pvf = {bflo(pv.x), bfhi(pv.x), bflo(pv.y), bfhi(pv.y)}, cvf = {bflo(cv.x), bfhi(cv.x), bflo(cv.y), bfhi(cv.y)}, nvf = {bflo(nv.x), bfhi(nv.x), bflo(nv.y), bfhi(nv.y)};
            const f32x4 pgf = {bflo(pg.x), bfhi(pg.x), bflo(pg.y), bfhi(pg.y)}, cgf = {bflo(cg.x), bfhi(cg.x), bflo(cg.y), bfhi(cg.y)}, ngf = {bflo(ng.x), bfhi(ng.x), bflo(ng.y), bfhi(ng.y)};
            const f32x4 val = wv0 * pvf + wv1 * cvf + wv2 * nvf + bv;
            const f32x4 gat = wg0 * pgf + wg1 * cgf + wg2 * ngf + bg;
            u32x2 o; o.x = pk2(gelu_tanh(gat[0]) * val[0], gelu_tanh(gat[1]) * val[1]); o.y = pk2(gelu_tanh(gat[2]) * val[2], gelu_tanh(gat[3]) * val[3]);
            *(u32x2*)(op + (size_t)i * DFF) = o;
        }
    }
}

#define BAR_LDS() do { asm volatile("s_waitcnt lgkmcnt(0)" ::: "memory"); __builtin_amdgcn_s_barrier(); asm volatile("" ::: "memory"); } while (0)
#define BAR_ALL() do { asm volatile("s_waitcnt vmcnt(0) lgkmcnt(0)" ::: "memory"); __builtin_amdgcn_s_barrier(); asm volatile("" ::: "memory"); } while (0)
template <int DK, bool ML>
DI void mixer_item(const int tid_in, unsigned char* smem, int S, int nch, int seq, int head, int dir, int split,
                   const bf16_t* Qg, const bf16_t* Kg, const bf16_t* KTg, const bf16_t* VTg, bf16_t* Hout, const float* gates, float lgv) {
    constexpr int KS = DK / 16, NST = DK / 128, NKP = DK * 16 / 512;
    int tid = tid_in; asm volatile("" : "+v"(tid));
    const int wid = __builtin_amdgcn_readfirstlane(tid >> 6), lane = tid & 63, l31 = lane & 31, hh = lane >> 5;
    const int vt = wid >> 2, tb = vt ? 7 - wid : wid;
#define MK_BASES(lo, to) \
    const unsigned l31x = ((lo) >> 4) & 31u, hhx = (lo) >> 9; \
    const unsigned a_ks = (unsigned)(vt * 2 * KS * 1024) + (lo); \
    const unsigned a_vt = (unsigned)(65536 + vt * 8 * 1024) + (lo); \
    const unsigned a_cs = (unsigned)(81920 + vt * KS * 1024) + (lo); \
    const unsigned a_ps = (unsigned)(114688 + tb * 8 * 1024) + (lo); \
    const unsigned a_psw = (unsigned)(114688 + (tb * 8 + vt * 4) * 1024) + l31x * 16 + 8 * hhx; \
    const unsigned a_csw = (unsigned)(81920 + (vt * KS + tb * 2) * 1024) + l31x * 16 + 8 * hhx; \
    const unsigned a_cp = (to); \
    const unsigned a_tv = (unsigned)(147456 + tb * 128) + l31x * 4; \
    const unsigned a_sv = (unsigned)(147456 + vt * 256) + 16 * hhx; \
    const unsigned a_hv = 147456u + hhx * 32; \
    const unsigned a_th = 147456u + ((to) >> 2);
    LAS unsigned char* const L = (LAS unsigned char*)smem;
#define LDSB(addr, off) (L + (addr) + (off))
#define LDG(T, base, off) (*(const T*)((const char*)(base) + (unsigned)(off)))
#define KDMA(Kptr, i) __builtin_amdgcn_global_load_lds((const unsigned*)((const char*)(Kptr) + (unsigned)(tofs + (i) * 8192)), (LAS unsigned*)(L + (unsigned)wid * 1024u + (i) * 8192), 16, 0, 0)
    {
        unsigned lo0 = lane * 16, to0 = tid * 16; asm volatile("" : "+v"(lo0), "+v"(to0));
        MK_BASES(lo0, to0)
        (void)a_ks; (void)a_vt; (void)a_cs; (void)a_ps; (void)a_psw; (void)a_csw; (void)a_tv; (void)a_sv; (void)a_hv;
        for (int i = 0; i < 64 * DK * 2 / 16 / 512; ++i) *(LAS u32x4*)LDSB(a_cp, 81920 + i * 8192) = (u32x4){0u, 0u, 0u, 0u};
        if (tid < 128) *(LAS float*)LDSB(a_th, 7 * 512) = 0.f;
        if (ML) {
#pragma unroll
            for (int i = 0; i < 3; ++i) {
                const unsigned ones = (i == 0 && (lo0 & (31u * 16u)) == 0u) ? 0x3F803F80u : 0u;
                *(LAS u32x4*)LDSB(a_cp, 32768 + i * 8192) = (u32x4){ones, ones, ones, ones};
            }
        }
    }
    f32x16 stC[NST];
    f32x16 stX;
#pragma unroll
    for (int r = 0; r < 16; ++r) stX[r] = 0.f;
#pragma unroll
    for (int i = 0; i < NST; ++i)
#pragma unroll
        for (int r = 0; r < 16; ++r) stC[i][r] = 0.f;
    float m = 0.f;
    const int last = dir ? 0 : 127;
    const int c0 = dir ? nch - 1 : 0;
    const size_t blk0 = ((size_t)seq * nch + c0) * 4 + head;
    bf16x8 qf[KS];
    u32x4 vtr[2];
    u32x4 kst[NKP];
    bf16x8 qfn[KS];
    float g_b = 0.f, g_pm = 0.f, g_cb = 0.f, g_pml = 0.f, g_cbl = 0.f;
    {
        unsigned lofs = lane * 16, tofs = tid * 16; asm volatile("" : "+v"(lofs), "+v"(tofs));
        const bf16_t* Kf = Kg + blk0 * (size_t)(128 * DK);
        if (ML) {
#pragma unroll
            for (int i = 0; i < NKP; ++i) kst[i] = LDG(u32x4, Kf, tofs + i * 8192);
        } else {
#pragma unroll
            for (int i = 0; i < NKP; ++i) KDMA(Kf, i);
        }
        const bf16_t* Qf = Qg + blk0 * (size_t)(128 * DK);
#pragma unroll
        for (int ks = 0; ks < KS; ++ks) qf[ks] = LDG(bf16x8, Qf + tb * KS * 512, lofs + ks * 1024);
        const bf16_t* VTf = VTg + blk0 * (size_t)(256 * 128) + split * (2 * 8 * 512);
#pragma unroll
        for (int i = 0; i < 2; ++i) vtr[i] = LDG(u32x4, VTf, tofs + i * 8192);
        if (ML) {
            const float* gp = gates + (((size_t)seq * nch + c0) * 2 + dir) * 4 * 384 + head * 384;
            g_pml = gp[128 + last]; g_cbl = gp[256 + last];
            if (tid < 128) { g_b = gp[tid]; g_pm = gp[128 + tid]; g_cb = gp[256 + tid]; }
        }
    }
    for (int ci = 0; ci < nch; ++ci) {
        const int c = dir ? nch - 1 - ci : ci;
        const bool has_next = ci + 1 < nch;
        unsigned lofs = lane * 16, tofs = tid * 16; asm volatile("" : "+v"(lofs), "+v"(tofs));
        float lgl = lgv; asm volatile("" : "+v"(lgl));
        const float rstep = ML ? 1.f : __expf(dir ? lgl : -lgl);
        MK_BASES(lofs, tofs)
        const int cn = dir ? c - 1 : c + 1;
        const size_t blk = ((size_t)seq * nch + c) * 4 + head;
        const size_t blkn = ((size_t)seq * nch + (has_next ? cn : c)) * 4 + head;
        const bf16_t* KTf = KTg + blk * (size_t)(DK * 128);
        const bf16_t* Kfn = Kg + blkn * (size_t)(128 * DK);
        if (ML) {
#pragma unroll
            for (int i = 0; i < NKP; ++i) *(LAS u32x4*)LDSB(a_cp, i * 8192) = kst[i];
        }
#pragma unroll
        for (int i = 0; i < 2; ++i) *(LAS u32x4*)LDSB(a_cp, 65536 + i * 8192) = vtr[i];
        float dec, m_new = 0.f;
        if (ML) {
            const float Ml = fmaxf(m, g_pml);
            dec = __expf(m - Ml); m_new = g_cbl + Ml;
            if (tid < 128) {
                const float M = fmaxf(m, g_pm);
                *(LAS float*)LDSB(a_th, 0) = g_b * 1.44269504089f; *(LAS float*)LDSB(a_th, 512) = M * 1.44269504089f; *(LAS float*)LDSB(a_th, 1024) = __expf(m - M);
                *(LAS float*)LDSB(a_th, 1536) = __expf(-g_cb - M); *(LAS float*)LDSB(a_th, 2048) = __expf(g_b - Ml); *(LAS float*)LDSB(a_th, 2560) = 0.f;
            }
        } else {
            dec = __expf(lgv * 128.f);
            if (ci == 0 && tid < 128) { *(LAS float*)LDSB(a_th, 1024) = __expf(lgv * (float)(dir ? (128 - tid) : (tid + 1))); *(LAS float*)LDSB(a_th, 2048) = __expf(lgv * (float)(dir ? tid : (127 - tid))); }
        }
        BAR_ALL();
        {
            float rsp = 0.f;
            const int t = tb * 32 + (int)l31x;
            const float Mtt = ML ? *(const LAS float*)LDSB(a_tv, 512) : 0.f;
#pragma unroll
            for (int sbi = 0; sbi < 2; ++sbi) {
                const int sb = vt * 2 + sbi;
                if (dir ? (sb < tb) : (sb > tb)) continue;
                f32x16 acc;
#pragma unroll
                for (int r = 0; r < 16; ++r) acc[r] = 0.f;
                {
                    bf16x8 fb[2][4];
#pragma unroll
                    for (int j = 0; j < 4; ++j) fb[0][j] = *(const LAS bf16x8*)LDSB(a_ks, (sbi * KS + j) * 1024);
#pragma unroll
                    for (int g = 0; g < KS / 4; ++g) {
                        if (g + 1 < KS / 4) {
#pragma unroll
                            for (int j = 0; j < 4; ++j) fb[(g + 1) & 1][j] = *(const LAS bf16x8*)LDSB(a_ks, (sbi * KS + (g + 1) * 4 + j) * 1024);
                        }
                        __builtin_amdgcn_sched_barrier(0);
#pragma unroll
                        for (int j = 0; j < 4; ++j) acc = MFMA32(fb[g & 1][j], qf[g * 4 + j], acc);
                        __builtin_amdgcn_sched_barrier(0);
                    }
                }
                const int mb = dir ? (t - sb * 32 - 4 * (int)hhx) : (sb * 32 + 4 * (int)hhx - t);
                float wk = 0.f, wr = 0.f;
                if (!ML) { wk = __expf(-lgl * (float)mb); wr = rstep; }
#pragma unroll
                for (int q = 0; q < 4; ++q) {
                    float v[4];
                    f32x4 bs4 = {0.f, 0.f, 0.f, 0.f};
                    if (ML) bs4 = *(const LAS f32x4*)LDSB(a_sv, (sbi * 32 + 8 * q) * 4);
#pragma unroll
                    for (int jj = 0; jj < 4; ++jj) {
                        const int k = 8 * q + jj;
                        const bool ok = mb <= (dir ? k : -k);
                        const float w = ML ? __builtin_amdgcn_exp2f(bs4[jj] - Mtt) : wk;
                        v[jj] = ok ? acc[q * 4 + jj] * w : 0.f;
                        rsp += v[jj];
                        if (!ML) wk *= wr;
                    }
                    if (!ML) { wk *= wr; wk *= wr; wk *= wr; wk *= wr; }
                    u32x2 o; o.x = pk2(v[0], v[1]); o.y = pk2(v[2], v[3]);
                    *(LAS u32x2*)LDSB(a_psw, (sbi * 2 + (q >> 1)) * 1024 + (q & 1) * 512) = o;
                }
            }
            (void)rsp;
        }
        BAR_LDS();
        if (has_next) {
            if (ML) {
#pragma unroll
                for (int i = 0; i < NKP; ++i) kst[i] = LDG(u32x4, Kfn, tofs + i * 8192);
                const bf16_t* Qfn = Qg + blkn * (size_t)(128 * DK);
#pragma unroll
                for (int ks = 0; ks < KS; ++ks) qfn[ks] = LDG(bf16x8, Qfn + tb * KS * 512, lofs + ks * 1024);
                const bf16_t* VTfn = VTg + blkn * (size_t)(256 * 128) + split * (2 * 8 * 512);
#pragma unroll
                for (int i = 0; i < 2; ++i) vtr[i] = LDG(u32x4, VTfn, tofs + i * 8192);
                const float* gp = gates + (((size_t)seq * nch + cn) * 2 + dir) * 4 * 384 + head * 384;
                g_pml = gp[128 + last]; g_cbl = gp[256 + last];
                if (tid < 128) { g_b = gp[tid]; g_pm = gp[128 + tid]; g_cb = gp[256 + tid]; }
            } else {
#pragma unroll
                for (int i = 0; i < NKP; ++i) KDMA(Kfn, i);
            }
        }
        bf16x8 kt[8];
        {
            f32x16 a1, a2;
#pragma unroll
            for (int r = 0; r < 16; ++r) { a1[r] = 0.f; a2[r] = 0.f; }
            f32x16 a1x, a2x;
#pragma unroll
            for (int r = 0; r < 16; ++r) { a1x[r] = 0.f; a2x[r] = 0.f; }
            {
#pragma unroll
                for (int g = 0; g < 4; ++g) {
                    if (dir ? (g < tb) : (g > tb)) continue;
                    const bf16x8 fa0 = *(const LAS bf16x8*)LDSB(a_vt, (g * 2) * 1024), fa1 = *(const LAS bf16x8*)LDSB(a_vt, (g * 2 + 1) * 1024);
                    const bf16x8 fp0 = *(const LAS bf16x8*)LDSB(a_ps, (g * 2) * 1024), fp1 = *(const LAS bf16x8*)LDSB(a_ps, (g * 2 + 1) * 1024);
                    a1 = MFMA32(fa0, fp0, a1); a1 = MFMA32(fa1, fp1, a1);
                    if (ML) {
                        const bf16x8 fx0 = *(const LAS bf16x8*)(L + lofs + 32768u + (g * 2) * 1024), fx1 = *(const LAS bf16x8*)(L + lofs + 32768u + (g * 2 + 1) * 1024);
                        a1x = MFMA32(fx0, fp0, a1x); a1x = MFMA32(fx1, fp1, a1x);
                    }
                }
                bf16x8 fc[2][4];
#pragma unroll
                for (int j = 0; j < 4; ++j) fc[0][j] = *(const LAS bf16x8*)LDSB(a_cs, j * 1024);
#pragma unroll
                for (int g = 0; g < KS / 4; ++g) {
                    if (g + 1 < KS / 4) {
#pragma unroll
                        for (int j = 0; j < 4; ++j) fc[(g + 1) & 1][j] = *(const LAS bf16x8*)LDSB(a_cs, ((g + 1) * 4 + j) * 1024);
                    }
                    __builtin_amdgcn_sched_barrier(0);
#pragma unroll
                    for (int j = 0; j < 4; ++j) a2 = MFMA32(fc[g & 1][j], qf[g * 4 + j], a2);
                    __builtin_amdgcn_sched_barrier(0);
                }
            }
            if (ML) {
#pragma unroll
                for (int ks = 0; ks < KS; ++ks) { const bf16x8 fcx = *(const LAS bf16x8*)(L + lofs + 49152u + ks * 1024); a2x = MFMA32(fcx, qf[ks], a2x); }
            }
#pragma unroll
            for (int ks = 0; ks < 8; ++ks) kt[ks] = LDG(bf16x8, KTf + tb * 8 * 512, lofs + ks * 1024);
            const int t = tb * 32 + (int)l31x; const float wi = *(const LAS float*)LDSB(a_tv, 2 * 512); float inv = 1.f;
            if (ML) { const float d0v = a1x[0] + wi * a2x[0]; const float dsw = __shfl_xor(d0v, 32); const float den = hhx ? dsw : d0v; inv = frcp(fmaxf(fabsf(den), *(const LAS float*)LDSB(a_tv, 3 * 512))); }
            bf16_t* hp = Hout + ((size_t)seq * S + (size_t)c * 128 + t) * DM + head * 256 + split * 64 + vt * 32;
            u32x2 oq[4];
#pragma unroll
            for (int q = 0; q < 4; ++q) {
                oq[q].x = pk2((a1[q * 4] + wi * a2[q * 4]) * inv, (a1[q * 4 + 1] + wi * a2[q * 4 + 1]) * inv);
                oq[q].y = pk2((a1[q * 4 + 2] + wi * a2[q * 4 + 2]) * inv, (a1[q * 4 + 3] + wi * a2[q * 4 + 3]) * inv);
            }
#pragma unroll
            for (int pr = 0; pr < 2; ++pr) {
                const u32x2 keep = hhx ? oq[2 * pr + 1] : oq[2 * pr];
                const u32x2 send = hhx ? oq[2 * pr] : oq[2 * pr + 1];
                u32x2 recv; recv.x = (unsigned)__shfl_xor((int)send.x, 32); recv.y = (unsigned)__shfl_xor((int)send.y, 32);
                const u32x4 w = hhx ? (u32x4){recv.x, recv.y, keep.x, keep.y} : (u32x4){keep.x, keep.y, recv.x, recv.y};
                *(u32x4*)(hp + 8 * (2 * pr + (int)hhx)) = w;
            }
        }
        BAR_LDS();
        if (!ML && has_next) {
            const bf16_t* VTfn = VTg + blkn * (size_t)(256 * 128) + split * (2 * 8 * 512);
#pragma unroll
            for (int i = 0; i < 2; ++i) vtr[i] = LDG(u32x4, VTfn, tofs + i * 8192);
        }
#pragma unroll
        for (int i = 0; i < 2; ++i) {
            const unsigned pidx = (unsigned)i * 512u + (tofs >> 4);
            const unsigned s0 = ((pidx >> 6) & 7u) * 16u + ((pidx >> 5) & 1u) * 8u;
            const u32x4 vv = *(const LAS u32x4*)LDSB(a_cp, 65536 + i * 8192);
            const f32x4 w0 = *(const LAS f32x4*)(L + 147456u + 4u * 512u + s0 * 4u), w1 = *(const LAS f32x4*)(L + 147456u + 4u * 512u + s0 * 4u + 16u);
            u32x4 o;
            o.x = pk2(bflo(vv.x) * w0[0], bfhi(vv.x) * w0[1]); o.y = pk2(bflo(vv.y) * w0[2], bfhi(vv.y) * w0[3]);
            o.z = pk2(bflo(vv.z) * w1[0], bfhi(vv.z) * w1[1]); o.w = pk2(bflo(vv.w) * w1[2], bfhi(vv.w) * w1[3]);
            *(LAS u32x4*)LDSB(a_cp, 114688 + i * 8192) = o;
        }
        if (ML && tid < 16) {
            const unsigned s0 = (unsigned)(tid >> 1) * 16u + (unsigned)(tid & 1) * 8u;
            const f32x4 w0 = *(const LAS f32x4*)(L + 147456u + 4u * 512u + s0 * 4u), w1 = *(const LAS f32x4*)(L + 147456u + 4u * 512u + s0 * 4u + 16u);
            u32x4 o; o.x = pk2(w0[0], w0[1]); o.y = pk2(w0[2], w0[3]); o.z = pk2(w1[0], w1[1]); o.w = pk2(w1[2], w1[3]);
            *(LAS u32x4*)(L + 40960u + ((unsigned)(tid >> 1) * 64u + 32u * (unsigned)(tid & 1)) * 16u) = o;
        }
        BAR_LDS();
        bf16x8 fv[8];
#pragma unroll
        for (int ks = 0; ks < 8; ++ks) fv[ks] = *(const LAS bf16x8*)LDSB(a_vt, (114688 - 65536) + ks * 1024);
#pragma unroll
        for (int i = 0; i < NST; ++i) {
            bf16x8 ktn[8];
            if (i + 1 < NST) {
#pragma unroll
                for (int ks = 0; ks < 8; ++ks) ktn[ks] = LDG(bf16x8, KTf + (tb + 4 * (i + 1)) * 8 * 512, lofs + ks * 1024);
            }
            if (ML && vt == 0) {
#pragma unroll
                for (int r = 0; r < 16; ++r) stX[r] *= dec;
#pragma unroll
                for (int ks = 0; ks < 8; ++ks) { const bf16x8 fw = *(const LAS bf16x8*)(L + lofs + 40960u + ks * 1024); stX = MFMA32(kt[ks], fw, stX); }
#pragma unroll
                for (int q = 0; q < 4; ++q) {
                    u32x2 o; o.x = pk2(stX[q * 4], stX[q * 4 + 1]); o.y = pk2(stX[q * 4 + 2], stX[q * 4 + 3]);
                    *(LAS u32x2*)(L + 49152u + (unsigned)((tb * 2 + (q >> 1)) * 1024 + (q & 1) * 512) + l31x * 16u + 8u * hhx) = o;
                }
            }
#pragma unroll
            for (int r = 0; r < 16; ++r) stC[i][r] *= dec;
            __builtin_amdgcn_sched_barrier(0);
#pragma unroll
            for (int ks = 0; ks < 8; ++ks) stC[i] = MFMA32(kt[ks], fv[ks], stC[i]);
            __builtin_amdgcn_sched_barrier(0);
#pragma unroll
            for (int q = 0; q < 4; ++q) {
                u32x2 o; o.x = pk2(stC[i][q * 4], stC[i][q * 4 + 1]); o.y = pk2(stC[i][q * 4 + 2], stC[i][q * 4 + 3]);
                *(LAS u32x2*)LDSB(a_csw, (8 * i + (q >> 1)) * 1024 + (q & 1) * 512) = o;
            }
            if (i + 1 < NST) {
#pragma unroll
                for (int ks = 0; ks < 8; ++ks) kt[ks] = ktn[ks];
            }
            if (NST > 1 && i == 0 && has_next) {
                const bf16_t* Qfn = Qg + blkn * (size_t)(128 * DK);
#pragma unroll
                for (int ks = 0; ks < KS; ++ks) qf[ks] = LDG(bf16x8, Qfn + tb * KS * 512, lofs + ks * 1024);
            }
        }
        if (ML && has_next) {
#pragma unroll
            for (int ks = 0; ks < KS; ++ks) qf[ks] = qfn[ks];
        }
        if (ML) m = m_new;
        BAR_LDS();
    }
#undef LDSB
#undef KDMA
#undef LDG
#undef MK_BASES
}

DI void phase_mixer(const Params& p, unsigned char* smem, int layer, int S, int nseq, int tid) {
    const int nch = S / 128, NI = nseq * 32;
    for (int it = blockIdx.x; it < 2 * NI; it += gridDim.x) {
        const int mixer = it / NI, r = it % NI;
        const int head = r & 3, dir = (r >> 2) & 1, split = (r >> 3) & 3, seq = r >> 5;
        if (mixer == 0) mixer_item<256, false>(tid, smem, S, nch, seq, head, dir, split, p.Qb, p.Kb, p.KbT, p.VbT, dir ? p.H3 : p.H2, nullptr, p.lg[layer * 8 + dir * 4 + head]);
        else mixer_item<128, true>(tid, smem, S, nch, seq, head, dir, split, p.Qa, p.Ka, p.KaT, p.VaT, dir ? p.H1 : p.H0, p.gates, 0.f);
    }
}


#define XB_TMO      128
#define XB_XCNT(j)  (256  + 64 * (j))
#define XB_XSUB(j)  (1280 + 64 * (j))
#define XB_XGEN(j)  (2304 + 64 * (j))
#define XB_TOP      3328
#define XB_TOPGEN   3392
#define XCD_BAR_WORDS 3456
#define XB_SPIN_CAP (1u << 22)
DI unsigned xb_ld(unsigned* p)              { return __hip_atomic_load(p, __ATOMIC_RELAXED, __HIP_MEMORY_SCOPE_AGENT); }
DI unsigned xb_add(unsigned* p, unsigned v) { return __hip_atomic_fetch_add(p, v, __ATOMIC_RELAXED, __HIP_MEMORY_SCOPE_AGENT); }
DI unsigned xb_xcc_id() { return (unsigned)__builtin_amdgcn_s_getreg((3 << 11) | 20) & 0xFu; }
#define XB_SPIN(cond, bar) do { unsigned _sp = 0; while (cond) { __builtin_amdgcn_s_sleep(1); \
    if ((++_sp & 255u) == 0u) { if (xb_ld(&(bar)[XB_TMO])) break; if (_sp > XB_SPIN_CAP) { atomicAdd(&(bar)[XB_TMO], 1u); break; } } } } while (0)
struct XcdBarrier { unsigned* bar; unsigned x; volatile LAS unsigned* st; };
DI XcdBarrier xcd_barrier_post(unsigned* bar, volatile LAS unsigned* st, int tid) {
    XcdBarrier b; b.bar = bar; b.x = xb_xcc_id(); b.st = st;
    if (tid == 0) (void)xb_add(&bar[XB_XCNT(b.x)], 1u);
    return b;
}
DI void xcd_barrier_complete(unsigned* bar, unsigned x, unsigned& nloc, unsigned& nx) {
    const unsigned G = gridDim.x * gridDim.y * gridDim.z;
    unsigned sum, cnt, mine, sp = 0u;
    for (;;) {
        sum = 0u; cnt = 0u; mine = 0u;
#pragma unroll
        for (unsigned j = 0; j < 16; ++j) { const unsigned c = xb_ld(&bar[XB_XCNT(j)]); sum += c; cnt += (c > 0u) ? 1u : 0u; mine = (j == x) ? c : mine; }
        if (sum == G) break;
        __builtin_amdgcn_s_sleep(1);
        if ((++sp & 255u) == 0u) { if (xb_ld(&bar[XB_TMO])) break; if (sp > XB_SPIN_CAP) { atomicAdd(&bar[XB_TMO], 1u); break; } }
    }
    nloc = mine > 0u ? mine : 1u; nx = cnt > 0u ? cnt : 1u;
}
DI void xcd_barrier(const XcdBarrier& b, int tid) {
    asm volatile("s_waitcnt vmcnt(0)" ::: "memory");
    __syncthreads();
    if (tid == 0) {
        unsigned* bar = b.bar;
        __builtin_amdgcn_s_waitcnt(0);
        unsigned nloc = b.st[0], nx = b.st[1];
        if (nloc == 0u) { xcd_barrier_complete(bar, b.x, nloc, nx); b.st[0] = nloc; b.st[1] = nx; }
        const unsigned old = xb_add(&bar[XB_XSUB(b.x)], 1u);
        const unsigned gen = old / nloc;
        if (old + 1u == (gen + 1u) * nloc) {
            __builtin_amdgcn_fence(__ATOMIC_RELEASE, "agent");
            asm volatile("s_waitcnt vmcnt(0)" ::: "memory");
            const unsigned og = xb_add(&bar[XB_TOP], 1u);
            const unsigned tg = og / nx;
            if (og + 1u == (tg + 1u) * nx) xb_add(&bar[XB_TOPGEN], 1u);
            else XB_SPIN(xb_ld(&bar[XB_TOPGEN]) == tg, bar);
            __builtin_amdgcn_fence(__ATOMIC_ACQUIRE, "agent");
            xb_add(&bar[XB_XGEN(b.x)], 1u);
            asm volatile("s_waitcnt vmcnt(0)" ::: "memory");
        } else {
            XB_SPIN(xb_ld(&bar[XB_XGEN(b.x)]) == gen, bar);
            __builtin_amdgcn_fence(__ATOMIC_ACQUIRE, "agent");
            asm volatile("s_waitcnt vmcnt(0)" ::: "memory");
        }
    }
    __syncthreads();
}

DI size_t al256(size_t x) { return (x + 255) & ~(size_t)255; }
DI void build_params(Params& p, const KArgs& a, char* w, int G) {
    p.x_prompt = a.in[0]; p.x_sample = a.in[1]; p.ln_in_g = a.in[2]; p.ln_in_b = a.in[3]; p.w_in = a.in[4]; p.b_if = a.in[5]; p.lg = a.in[6]; p.g_a = a.in[7]; p.g_b = a.in[8];
    p.w_o = a.in[9]; p.ln1_g = a.in[10]; p.ln1_b = a.in[11]; p.w_up = a.in[12]; p.conv_w = a.in[13]; p.conv_b = a.in[14]; p.w_down = a.in[15]; p.ln2_g = a.in[16]; p.ln2_b = a.in[17];
    p.out = a.out; p.G = G; p.pad = 0;
    size_t o = 0;
    p.WinT = (bf16_t*)(w + o); o += al256((size_t)2 * NW * DM * 2);
    p.WoT = (bf16_t*)(w + o); o += al256((size_t)2 * DM * DM * 2);
    p.WupT = (bf16_t*)(w + o); o += al256((size_t)2 * NUP * DM * 2);
    p.WdT = (bf16_t*)(w + o); o += al256((size_t)2 * DM * DFF * 2);
    p.cosT = (float*)(w + o); o += (size_t)4096 * 128 * 4; p.sinT = (float*)(w + o); o += (size_t)4096 * 128 * 4;
    p.cosTT = (float*)(w + o); o += (size_t)4096 * 128 * 4; p.sinTT = (float*)(w + o); o += (size_t)4096 * 128 * 4;
    p.gates = (float*)(w + o); o += (size_t)G * 96;
    p.gpre = (float*)(w + o); o += (size_t)G * 64;
    p.WgT = (bf16_t*)(w + o); o += 65536;
    char* ubase = w + o;
    const size_t g1 = (size_t)G * 1024;
    p.Qb = (bf16_t*)(w + o); o += 2 * g1; p.Kb = (bf16_t*)(w + o); o += 2 * g1;
    p.Qa = (bf16_t*)(w + o); o += g1; p.Ka = (bf16_t*)(w + o); o += g1;
    p.E = (bf16_t*)(w + o); o += 8 * g1;
    p.KbT = (bf16_t*)(w + o); o += 2 * g1; p.KaT = (bf16_t*)(w + o); o += g1;
    p.VaT = (bf16_t*)(w + o); o += 2 * g1; p.VbT = (bf16_t*)(w + o); o += 2 * g1;
    p.H0 = (bf16_t*)(w + o); o += 2 * g1; p.H1 = (bf16_t*)(w + o); o += 2 * g1;
    p.H2 = (bf16_t*)(w + o); o += 2 * g1; p.H3 = (bf16_t*)(w + o); o += 2 * g1;
    p.xb = p.H0; p.merged = (bf16_t*)ubase; p.hu = (bf16_t*)ubase; p.ff = (bf16_t*)(ubase + (size_t)G * NUP * 2);
}
DI void run_phase(const Params& p, unsigned char* smem, int ph, const int tid) {
    const int G = p.G;
    const int g = (ph - 1) / 19, q = (ph - 1) % 19;
    const int T0 = g * G;
    const int S = T0 < TPROMPT ? 2048 : 4096;
    const int nseq = G / S;
    float* xg = p.out + (size_t)T0 * DM;
    bf16_t* xin = (bf16_t*)xg;
    bf16_t* yb = p.H2;
    LAS unsigned char* lds = (LAS unsigned char*)smem;
    if (q == 0) return;
    const int l = (q - 1) / 9, k = (q - 1) % 9;
    pg8::StaticOrder so;
    switch (k) {
    case 0: {
        { pg8::Gemm gm{xin, p.WinT + (size_t)l * NW * DM, G, NNORM, DM}; so.init(gm.M, gm.N, (int)gridDim.x, (int)blockIdx.x); EpiInN e{&p, S, smem}; pg8::gemm_phase(lds, gm, so, e, tid); }
        { pg8::Gemm gm{p.WinT + ((size_t)l * NW + NNORM) * DM, xin, NTR, G, DM}; so.init(gm.M, gm.N, (int)gridDim.x, (int)blockIdx.x); EpiInT e{&p, S}; pg8::gemm_phase(lds, gm, so, e, tid); }
        phase_gates2(p, smem, l, xin, G / 128, tid);
    } break;
    case 1: phase_mixer(p, smem, l, S, nseq, tid); break;
    case 2: phase_merge(p, l, G, tid); break;
    case 3: { pg8::Gemm gm{p.merged, p.WoT + (size_t)l * DM * DM, G, DM, DM}; so.init(gm.M, gm.N, (int)gridDim.x, (int)blockIdx.x); EpiB16 e{yb, DM}; pg8::gemm_phase(lds, gm, so, e, tid); } break;
    case 4: phase_ln(yb, 2, xin, p.ln1_g + l * DM, p.ln1_b + l * DM, nullptr, p.xb, G, tid, smem, nullptr, nullptr, nullptr); break;
    case 5: { pg8::Gemm gm{p.xb, p.WupT + (size_t)l * NUP * DM, G, NUP, DM}; so.init(gm.M, gm.N, (int)gridDim.x, (int)blockIdx.x); EpiB16 e{p.hu, NUP}; pg8::gemm_phase(lds, gm, so, e, tid); } break;
    case 6: phase_conv(p, l, G, S, tid); break;
    case 7: { pg8::Gemm gm{p.ff, p.WdT + (size_t)l * DM * DFF, G, DM, DFF}; so.init(gm.M, gm.N, (int)gridDim.x, (int)blockIdx.x); EpiB16 e{yb, DM}; pg8::gemm_phase(lds, gm, so, e, tid); } break;
    default: {
        const int T1 = T0 + G;
        const int nrep = (l == 1 && T1 < TTOT) ? 2 : 1;
        _Pragma("nounroll") for (int rep = 0; rep < nrep; ++rep) {
            const void* src; const float* gg; const float* bb; float* df; bf16_t* db;
            if (rep == 0) { src = yb; gg = p.ln2_g + l * DM; bb = p.ln2_b + l * DM; df = l == 1 ? xg : nullptr; db = l == 1 ? nullptr : xin; }
            else { src = T1 < TPROMPT ? p.x_prompt + (size_t)T1 * DM : p.x_sample + (size_t)(T1 - TPROMPT) * DM; gg = p.ln_in_g; bb = p.ln_in_b; df = nullptr; db = (bf16_t*)(p.out + (size_t)T1 * DM); }
            phase_ln(src, rep == 0 ? 2 : 0, p.xb, gg, bb, df, db, G, tid, smem, nullptr, nullptr, nullptr);
        }
    } break;
    }
}

__global__ __launch_bounds__(512, 2) void mega(KArgs a, int ph_lo, int ph_hi) {
    extern __shared__ __attribute__((aligned(16))) unsigned char smem[];
    const int wid0 = __builtin_amdgcn_readfirstlane((int)threadIdx.x >> 6);
#define MK_TID() (wid0 * 64 + (int)__builtin_amdgcn_mbcnt_hi(~0u, __builtin_amdgcn_mbcnt_lo(~0u, 0u)))
    const bool multi = ph_hi - ph_lo > 1;
    XcdBarrier xb; xb.bar = a.bar; xb.x = 0; xb.st = (volatile LAS unsigned*)((LAS unsigned char*)smem + 151552);
    if (multi) {
        int tid1 = MK_TID(); asm volatile("" : "+v"(tid1));
        if (tid1 == 0) { xb.st[0] = 0u; xb.st[1] = 0u; }
        __syncthreads();
        xb = xcd_barrier_post(a.bar, xb.st, tid1);
    }
    if (ph_hi < -1000) cg::this_grid().sync();
    if (ph_lo == 0) {
        int tid0 = MK_TID(); asm volatile("" : "+v"(tid0));
        Params p; build_params(p, a, a.ws, a.G);
        phase_prep(p, tid0);
        phase_ln(p.x_prompt, 0, nullptr, p.ln_in_g, p.ln_in_b, nullptr, (bf16_t*)p.out, a.G, tid0, smem, nullptr, nullptr, nullptr);
        ph_lo = 1;
        if (ph_lo < ph_hi) xcd_barrier(xb, tid0);
    }
    for (int ph = ph_lo; ph < ph_hi; ++ph) {
        int wq = wid0; asm volatile("" : "+s"(wq));
        int tid = wq * 64 + (int)__builtin_amdgcn_mbcnt_hi(~0u, __builtin_amdgcn_mbcnt_lo(~0u, 0u)); asm volatile("" : "+v"(tid));
        int G = a.G; char* w = a.ws; asm volatile("" : "+s"(G));
        Params p; build_params(p, a, w, G);
        if ((ph - 1) % 19 == 0) continue;
        run_phase(p, smem, ph, tid);
        if (ph + 1 < ph_hi) xcd_barrier(xb, tid);
    }
}

#ifndef ONE_LAUNCH
#define ONE_LAUNCH 1
#endif

extern "C" void kernel_launch(void* const* d_in, const int* in_sizes, int n_in, void* d_out, int out_size, void* d_ws, size_t ws_size, hipStream_t stream) {
    static int grid = 0;
    if (grid == 0) {
        int dev = 0, cus = 0, per_cu = 0;
        hipGetDevice(&dev);
        hipDeviceGetAttribute(&cus, hipDeviceAttributeMultiprocessorCount, dev);
        hipFuncSetAttribute((const void*)mega, hipFuncAttributeMaxDynamicSharedMemorySize, LDS_BYTES);
        hipOccupancyMaxActiveBlocksPerMultiprocessor(&per_cu, (const void*)mega, 512, LDS_BYTES);
        (void)hipGetLastError();
        if (per_cu < 1) per_cu = 1;
        if (cus <= 0) cus = 256;
        grid = cus;
    }
    KArgs p{};
    for (int i = 0; i < 18; ++i) p.in[i] = (const float*)d_in[i];
    p.out = (float*)d_out; p.ws = (char*)d_ws + 16384; p.bar = (unsigned*)d_ws;
    auto need = [](size_t G) { return (size_t)2 * NW * DM * 2 + (size_t)2 * DM * DM * 2 + (size_t)2 * NUP * DM * 2 + (size_t)2 * DM * DFF * 2 + (size_t)4 * 4096 * 128 * 4 + G * 160 + G * (size_t)(NW) * 2 + G * (size_t)4 * DM * 2 + 4096 + 16384 + 65536; };
    int G = 32768;
    if (need(G) > ws_size) G = 16384;
    p.G = G;
    const int ngroups = TTOT / G;
    const int nph = 1 + ngroups * 19;
#if ONE_LAUNCH
    hipMemsetAsync(d_ws, 0, 16384, stream);
    int lo = 0, hi = nph;
    void* args[] = {&p, &lo, &hi};
    hipError_t e = hipLaunchCooperativeKernel((const void*)mega, dim3(grid), dim3(512), args, LDS_BYTES, stream);
    if (e != hipSuccess) fprintf(stderr, "cooperative launch failed: %s (grid %d)\n", hipGetErrorString(e), grid);
#else
    for (int ph = 0; ph < nph; ++ph) hipLaunchKernelGGL(mega, dim3(grid), dim3(512), LDS_BYTES, stream, p, ph, ph + 1);
#endif
}
```

```cpp
#include <hip/hip_runtime.h>
#include <hip/hip_cooperative_groups.h>
#include <cstdio>
namespace cg = cooperative_groups;

#define LAS __attribute__((address_space(3)))
#define DI __device__ __forceinline__
typedef unsigned short bf16_t;
typedef short bf16x8 __attribute__((ext_vector_type(8)));
typedef float f32x4 __attribute__((ext_vector_type(4)));
typedef float f32x16 __attribute__((ext_vector_type(16)));
typedef unsigned u32x4 __attribute__((ext_vector_type(4)));
typedef unsigned u32x2 __attribute__((ext_vector_type(2)));

constexpr int DM = 1024, NIN = 9232, DFF = 2816, NUP = 5632;
constexpr int NNORM = 7168, NTR = 2048, NW = NNORM + NTR;
constexpr int TTOT = 98304, TPROMPT = 65536;
constexpr int LDS_BYTES = 151552 + 16;
constexpr float ALPHA = 1.41421356237f;
constexpr float LN_EPS = 1e-5f;

struct KArgs {
    const float* in[18];
    float* out; char* ws; unsigned* bar;
    int G; int pad;
};
struct Params {
    const float* x_prompt; const float* x_sample; const float* ln_in_g; const float* ln_in_b; const float* w_in; const float* b_if;
    const float* lg; const float* g_a; const float* g_b; const float* w_o; const float* ln1_g; const float* ln1_b; const float* w_up;
    const float* conv_w; const float* conv_b; const float* w_down; const float* ln2_g; const float* ln2_b;
    float* out;
    bf16_t* WinT; bf16_t* WoT; bf16_t* WupT; bf16_t* WdT;
    float* cosT; float* sinT; float* cosTT; float* sinTT;
    float* gates; float* gpre; bf16_t* WgT;
    bf16_t* Qb; bf16_t* Kb; bf16_t* Qa; bf16_t* Ka; bf16_t* E; bf16_t* KbT; bf16_t* KaT; bf16_t* VaT; bf16_t* VbT;
    bf16_t* H0; bf16_t* H1; bf16_t* H2; bf16_t* H3;
    bf16_t* xb; bf16_t* merged; bf16_t* hu; bf16_t* ff;
    int G; int pad;
};

typedef float f32x2 __attribute__((ext_vector_type(2)));
typedef __bf16 bf16v2 __attribute__((ext_vector_type(2)));
DI unsigned f2bf(float x) { unsigned u = __float_as_uint(x); u += 0x7fffu + ((u >> 16) & 1u); return u >> 16; }
DI unsigned pk2(float lo, float hi) { const f32x2 v = {lo, hi}; return __builtin_bit_cast(unsigned, __builtin_convertvector(v, bf16v2)); }
DI float bflo(unsigned w) { return __uint_as_float(w << 16); }
DI float bfhi(unsigned w) { return __uint_as_float(w & 0xffff0000u); }
DI float frcp(float x) { return __builtin_amdgcn_rcpf(x); }
DI float sigmoidf_(float x) { return frcp(1.f + __expf(-x)); }
#define MFMA32(a, b, c) __builtin_amdgcn_mfma_f32_32x32x16_bf16((a), (b), (c), 0, 0, 0)

namespace pg8 {
constexpr int BM = 256, BK = 64, HALF = 128, HTB = HALF * BK * 2, STAGE_BYTES = 8 * HTB, NXCD = 8, WGM = 8;
DI int lds_byte(int r, int c) { const int st = (r >> 4) * 2 + (c >> 5), rr = r & 15, cc = c & 31, ob = rr * 64 + cc * 2; return st * 1024 + (ob ^ (((ob >> 9) & 1) << 5)); }
DI void stage_rc(int b, int& R, int& C) { const int st = b / 1024, sb = b % 1024, swz = sb ^ (((sb >> 9) & 1) << 5); R = (st >> 1) * 16 + swz / 64; C = (st & 1) * 32 + (swz % 64) / 2; }
DI int perm32(int rho) { const int n = rho >> 4, i = rho & 15; return 8 * (i >> 2) + 4 * n + (i & 3); }
struct Unit { int pm, pn; };
struct Gemm { const bf16_t* A; const bf16_t* Bt; int M, N, K; };
struct StaticOrder {
    int nM, nN, nwg, G, c;
    DI void init(int M, int N, int G_, int c_) { nM = M / BM; nN = N / BM; nwg = nM * nN; G = G_; c = c_; }
    DI bool next(int i, Unit& u) const {
        const long L = (long)i * G + c; if (L >= nwg) return false;
        int wgid = (int)L; { const int q = nwg / NXCD, r = nwg % NXCD, xcd = wgid % NXCD, off = wgid / NXCD; wgid = (xcd < r ? xcd * (q + 1) : r * (q + 1) + (xcd - r) * q) + off; }
        const int nig = WGM * nN, gid = wgid / nig, fm = gid * WGM, gsz = (nM - fm) < WGM ? (nM - fm) : WGM;
        u.pm = fm + ((wgid % nig) % gsz); u.pn = (wgid % nig) / gsz; return true;
    }
};

template <class Epi>
DI void gemm_phase(LAS unsigned char* lds, const Gemm g, const StaticOrder& S, const Epi& E, const int tid) {
    const int wid = __builtin_amdgcn_readfirstlane(tid >> 6), lane = tid & 63, wr = wid >> 2, wc = wid & 3, fr = lane & 15, fq = lane >> 4;
    const int K = g.K, nt = K / BK;
    unsigned voffA[2], voffB[2];
#pragma unroll
    for (int i = 0; i < 2; ++i) { int R, C; stage_rc(tid * 16 + i * 8192, R, C); const int Rb = Epi::PERM ? ((R & ~31) + perm32(R & 31)) : R;
        voffA[i] = (unsigned)(R * K + C) * 2u; voffB[i] = (unsigned)(Rb * K + C) * 2u; }
    const size_t kstep = (size_t)(BK * 2);
    const size_t hstep = (size_t)HALF * K * 2;
    const size_t tstep = 2 * hstep;
    const unsigned ldsw = (unsigned)wid * 1024u;
    const int aoff = lds_byte(wr * 64 + fr, fq * 8), boff = lds_byte(wc * 32 + fr, fq * 8);
#define PG8_SA(b, h) (((b) * 2 + (h)) * HTB)
#define PG8_SB(b, h) ((4 + (b) * 2 + (h)) * HTB)
#define PG8_STAGE(bufoff, gbase, voff) do { _Pragma("unroll") for (int _i = 0; _i < 2; ++_i) \
        __builtin_amdgcn_global_load_lds((const unsigned*)((const char*)(gbase) + (voff)[_i]), (LAS unsigned*)(lds + (bufoff) + ldsw + _i * 8192), 16, 0, 0); } while (0)
#define PG8_LDA(dst, b, h) do { _Pragma("unroll") for (int m = 0; m < 4; ++m) _Pragma("unroll") for (int k = 0; k < 2; ++k) dst[m][k] = *(const LAS bf16x8*)(lds + PG8_SA(b, h) + aoff + m * 2048 + k * 1024); } while (0)
#define PG8_LDB(dst, b, h) do { _Pragma("unroll") for (int n = 0; n < 2; ++n) _Pragma("unroll") for (int k = 0; k < 2; ++k) dst[n][k] = *(const LAS bf16x8*)(lds + PG8_SB(b, h) + boff + n * 2048 + k * 1024); } while (0)
#define PG8_MMA(ai, bj, At, Bt) do { __builtin_amdgcn_s_setprio(1); _Pragma("unroll") for (int m = 0; m < 4; ++m) _Pragma("unroll") for (int n = 0; n < 2; ++n) _Pragma("unroll") for (int k = 0; k < 2; ++k) \
        acc[ai][bj][m][n] = __builtin_amdgcn_mfma_f32_16x16x32_bf16(Bt[n][k], At[m][k], acc[ai][bj][m][n], 0, 0, 0); __builtin_amdgcn_s_setprio(0); } while (0)
#define PG8_WAIT_V(n) asm volatile("s_waitcnt vmcnt(" #n ")" ::: "memory")
#define PG8_WAIT_L(n) asm volatile("s_waitcnt lgkmcnt(" #n ")" ::: "memory")
#define PG8_BAR __builtin_amdgcn_s_barrier()
#define PG8_SCHED __builtin_amdgcn_sched_barrier(0)
    Unit cur, nxt; int ui = 0;
    if (!S.next(0, cur)) return;
    f32x4 acc[2][2][4][2];
#pragma unroll
    for (int a = 0; a < 2; ++a)
#pragma unroll
        for (int b = 0; b < 2; ++b)
#pragma unroll
            for (int m = 0; m < 4; ++m)
#pragma unroll
                for (int n = 0; n < 2; ++n) acc[a][b][m][n] = (f32x4){0.f, 0.f, 0.f, 0.f};
    bf16x8 At[4][2], B0[2][2], B1[2][2];
    const char* cA = (const char*)g.A + (size_t)cur.pm * tstep; const char* cB = (const char*)g.Bt + (size_t)cur.pn * tstep;
    PG8_STAGE(PG8_SB(0, 0), cB, voffB); PG8_STAGE(PG8_SA(0, 0), cA, voffA); PG8_STAGE(PG8_SB(0, 1), cB + hstep, voffB); PG8_STAGE(PG8_SA(0, 1), cA + hstep, voffA);
    if (wr == 1) PG8_BAR;
    PG8_WAIT_V(4); PG8_BAR;
    PG8_STAGE(PG8_SB(1, 0), cB + kstep, voffB); PG8_STAGE(PG8_SA(1, 0), cA + kstep, voffA); PG8_STAGE(PG8_SB(1, 1), cB + hstep + kstep, voffB);
    PG8_WAIT_V(6); PG8_BAR;
    for (;;) {
        const bool has_next = S.next(ui + 1, nxt);
        const char* nA = has_next ? (const char*)g.A + (size_t)nxt.pm * tstep : cA; const char* nB = has_next ? (const char*)g.Bt + (size_t)nxt.pn * tstep : cB;
        for (int t = 0; t < nt; t += 2) {
            const bool last = (t == nt - 2);
            const char* a1 = cA + (size_t)(t + 1) * kstep;
            const char* a2 = last ? nA : cA + (size_t)(t + 2) * kstep; const char* b2 = last ? nB : cB + (size_t)(t + 2) * kstep;
            const char* a3 = a2 + kstep; const char* b3 = b2 + kstep;
            PG8_LDB(B0, 0, 0); PG8_SCHED; PG8_LDA(At, 0, 0); PG8_STAGE(PG8_SA(1, 1), a1 + hstep, voffA);
            PG8_WAIT_L(8); PG8_BAR; PG8_WAIT_L(0); PG8_MMA(0, 0, At, B0); PG8_BAR; PG8_SCHED;
            PG8_LDB(B1, 0, 1); PG8_STAGE(PG8_SB(0, 0), b2, voffB);
            PG8_BAR; PG8_WAIT_L(0); PG8_MMA(0, 1, At, B1); PG8_BAR;
            PG8_LDA(At, 0, 1); PG8_STAGE(PG8_SA(0, 0), a2, voffA);
            PG8_BAR; PG8_WAIT_L(0); PG8_MMA(1, 0, At, B0); PG8_BAR; PG8_SCHED;
            PG8_STAGE(PG8_SB(0, 1), b2 + hstep, voffB);
            PG8_WAIT_V(6); PG8_BAR; PG8_MMA(1, 1, At, B1); PG8_BAR;
            PG8_LDB(B0, 1, 0); PG8_SCHED; PG8_LDA(At, 1, 0); PG8_STAGE(PG8_SA(0, 1), a2 + hstep, voffA);
            PG8_WAIT_L(8); PG8_BAR; PG8_WAIT_L(0); PG8_MMA(0, 0, At, B0); PG8_BAR; PG8_SCHED;
            PG8_LDB(B1, 1, 1); PG8_STAGE(PG8_SB(1, 0), b3, voffB);
            PG8_BAR; PG8_WAIT_L(0); PG8_MMA(0, 1, At, B1); PG8_BAR;
            PG8_LDA(At, 1, 1); PG8_STAGE(PG8_SA(1, 0), a3, voffA);
            PG8_BAR; PG8_WAIT_L(0); PG8_MMA(1, 0, At, B0); PG8_BAR; PG8_SCHED;
            PG8_STAGE(PG8_SB(1, 1), b3 + hstep, voffB);
            PG8_WAIT_V(6); PG8_BAR; PG8_MMA(1, 1, At, B1); PG8_BAR;
        }
        { int fr2 = fr, fq2 = fq; asm volatile("" : "+v"(fr2), "+v"(fq2)); E(acc, cur, wr, wc, fr2, fq2); }
        if (!has_next) break;
#pragma unroll
        for (int a = 0; a < 2; ++a)
#pragma unroll
            for (int b = 0; b < 2; ++b)
#pragma unroll
                for (int m = 0; m < 4; ++m)
#pragma unroll
                    for (int n = 0; n < 2; ++n) acc[a][b][m][n] = (f32x4){0.f, 0.f, 0.f, 0.f};
        cur = nxt; cA = nA; cB = nB; ++ui;
    }
    PG8_WAIT_V(0);
    if (wr == 0) PG8_BAR;
    PG8_BAR;
#undef PG8_SA
#undef PG8_SB
#undef PG8_STAGE
#undef PG8_LDA
#undef PG8_LDB
#undef PG8_MMA
#undef PG8_WAIT_V
#undef PG8_WAIT_L
#undef PG8_BAR
#undef PG8_SCHED
}
}

typedef f32x4 AccT[2][2][4][2];
DI u32x4 pack8(f32x4 a, f32x4 b) { u32x4 w; w.x = pk2(a[0], a[1]); w.y = pk2(a[2], a[3]); w.z = pk2(b[0], b[1]); w.w = pk2(b[2], b[3]); return w; }
DI size_t fragoff(int row, int kidx, int KS) { return (size_t)((((row >> 5) * KS + (kidx >> 4)) * 64 + (row & 31) + 32 * ((kidx >> 3) & 1)) * 8); }

DI void kt_store(unsigned char* sc, const u32x4 w, int fr, int fq, bf16_t* ktbase, int dbase, int sbase) {
    unsigned short* s16 = (unsigned short*)sc;
#pragma unroll
    for (int j = 0; j < 8; ++j) s16[(8 * fq + j) * 24 + fr] = (unsigned short)((w[j >> 1] >> (16 * (j & 1))) & 0xffffu);
    asm volatile("s_waitcnt lgkmcnt(0)" ::: "memory");
    const int L = fr + 16 * fq, fl = L >> 1, th = L & 1;
    const u32x4 r = *(const u32x4*)(sc + (fl * 24 + th * 8) * 2);
    asm volatile("s_waitcnt lgkmcnt(0)" ::: "memory");
    *(u32x4*)(ktbase + fragoff(dbase + fl, sbase + th * 8, 8)) = r;
}
struct EpiInN {
    static constexpr bool PERM = true;
    const Params* p; int S; unsigned char* smem;
    DI void operator()(const AccT& acc, const pg8::Unit& u, int wr, int wc, int fr, int fq) const {
        const int pn = u.pn;
        const int d0 = wc * 32 + 8 * fq;
        if (pn < 8) {
            bf16_t* dst = pn < 4 ? p->Qb : p->Kb; const int head = pn & 3;
#pragma unroll
            for (int ai = 0; ai < 2; ++ai)
#pragma unroll
                for (int m = 0; m < 4; ++m) {
                    const int row = u.pm * 256 + ai * 128 + wr * 64 + m * 16 + fr; const int pos = row % S; const int chunk = row >> 7, t = row & 127;
                    const f32x4 c0 = *(const f32x4*)(p->cosT + pos * 128 + d0), c1 = *(const f32x4*)(p->cosT + pos * 128 + d0 + 4);
                    const f32x4 s0 = *(const f32x4*)(p->sinT + pos * 128 + d0), s1 = *(const f32x4*)(p->sinT + pos * 128 + d0 + 4);
                    const f32x4 x10 = acc[ai][0][m][0], x11 = acc[ai][0][m][1], x20 = acc[ai][1][m][0], x21 = acc[ai][1][m][1];
                    const f32x4 o10 = x10 * c0 - x20 * s0, o11 = x11 * c1 - x21 * s1, o20 = x10 * s0 + x20 * c0, o21 = x11 * s1 + x21 * c1;
                    bf16_t* base = dst + (size_t)(chunk * 4 + head) * (128 * 256);
                    const u32x4 w1 = pack8(o10, o11), w2 = pack8(o20, o21);
                    *(u32x4*)(base + fragoff(t, d0, 16)) = w1;
                    *(u32x4*)(base + fragoff(t, d0 + 128, 16)) = w2;
                    if (pn >= 4) {
                        unsigned char* sc = smem + 131072 + (wr * 4 + wc) * 2048;
                        bf16_t* ktb = p->KbT + (size_t)(chunk * 4 + head) * (256 * 128);
                        kt_store(sc, w1, fr, fq, ktb, wc * 32, wr * 64 + m * 16);
                        kt_store(sc, w2, fr, fq, ktb, 128 + wc * 32, wr * 64 + m * 16);
                    }
                }
        } else if (pn < 12) {
            bf16_t* dst = pn < 10 ? p->Qa : p->Ka;
#pragma unroll
            for (int ai = 0; ai < 2; ++ai)
#pragma unroll
                for (int m = 0; m < 4; ++m) {
                    const int row = u.pm * 256 + ai * 128 + wr * 64 + m * 16 + fr; const int chunk = row >> 7, t = row & 127;
#pragma unroll
                    for (int bj = 0; bj < 2; ++bj) {
                        const int head = ((pn - 8) & 1) * 2 + bj;
                        bf16_t* base = dst + (size_t)(chunk * 4 + head) * (128 * 128);
                        const u32x4 w1 = pack8(acc[ai][bj][m][0], acc[ai][bj][m][1]);
                        *(u32x4*)(base + fragoff(t, d0, 8)) = w1;
                        if (pn >= 10) kt_store(smem + 131072 + (wr * 4 + wc) * 2048, w1, fr, fq, p->KaT + (size_t)(chunk * 4 + head) * (128 * 128), wc * 32, wr * 64 + m * 16);
                    }
                }
        } else {
#pragma unroll
            for (int ai = 0; ai < 2; ++ai)
#pragma unroll
                for (int m = 0; m < 4; ++m) {
                    const int row = u.pm * 256 + ai * 128 + wr * 64 + m * 16 + fr;
                    bf16_t* rp = p->E + (size_t)row * 4096 + (pn - 12) * 256 + d0;
#pragma unroll
                    for (int bj = 0; bj < 2; ++bj) *(u32x4*)(rp + bj * 128) = pack8(acc[ai][bj][m][0], acc[ai][bj][m][1]);
                }
        }
    }
};
struct EpiInT {
    static constexpr bool PERM = true;
    const Params* p; int S;
    DI void operator()(const AccT& acc, const pg8::Unit& u, int wr, int wc, int fr, int fq) const {
        const int pm = u.pm;
        const int s0 = wc * 32 + 8 * fq;
        bf16_t* dst = pm < 4 ? p->VaT : p->VbT; const int head = pm & 3;
#pragma unroll
        for (int ai = 0; ai < 2; ++ai)
#pragma unroll
            for (int bj = 0; bj < 2; ++bj) {
                const int chunk = u.pn * 2 + bj;
                bf16_t* base = dst + (size_t)(chunk * 4 + head) * (256 * 128);
#pragma unroll
                for (int m = 0; m < 4; ++m) { const int v = ai * 128 + wr * 64 + m * 16 + fr; *(u32x4*)(base + fragoff(v, s0, 8)) = pack8(acc[ai][bj][m][0], acc[ai][bj][m][1]); }
            }
    }
};
template <bool XB> struct EpiRes {
    static constexpr bool PERM = false;
    float* Y;
    const bf16_t* X;
    DI void operator()(const AccT& acc, const pg8::Unit& u, int wr, int wc, int fr, int fq) const {
        const int row0 = u.pm * 256 + wr * 64 + fr, col0 = u.pn * 256 + wc * 32 + 4 * fq;
#pragma unroll
        for (int ai = 0; ai < 2; ++ai) {
            f32x4 xv[4][2][2];
#pragma unroll
            for (int m = 0; m < 4; ++m)
#pragma unroll
                for (int bj = 0; bj < 2; ++bj)
#pragma unroll
                    for (int n = 0; n < 2; ++n) {
                        const size_t off = (size_t)(row0 + ai * 128 + m * 16) * DM + col0 + bj * 128 + n * 16;
                        if (XB) { const u32x2 xw = *(const u32x2*)(X + off); xv[m][bj][n] = (f32x4){bflo(xw.x), bfhi(xw.x), bflo(xw.y), bfhi(xw.y)}; }
                        else xv[m][bj][n] = *(const f32x4*)(Y + off);
                    }
#pragma unroll
            for (int m = 0; m < 4; ++m)
#pragma unroll
                for (int bj = 0; bj < 2; ++bj)
#pragma unroll
                    for (int n = 0; n < 2; ++n) {
                        const size_t off = (size_t)(row0 + ai * 128 + m * 16) * DM + col0 + bj * 128 + n * 16;
                        *(f32x4*)(Y + off) = xv[m][bj][n] * ALPHA + acc[ai][bj][m][n];
                    }
        }
    }
};
struct EpiB16 {
    static constexpr bool PERM = true;
    bf16_t* O; int ldc;
    DI void operator()(const AccT& acc, const pg8::Unit& u, int wr, int wc, int fr, int fq) const {
        const int row0 = u.pm * 256 + wr * 64 + fr, col0 = u.pn * 256 + wc * 32 + 8 * fq;
#pragma unroll
        for (int ai = 0; ai < 2; ++ai)
#pragma unroll
            for (int m = 0; m < 4; ++m) { bf16_t* rp = O + (size_t)(row0 + ai * 128 + m * 16) * ldc + col0;
#pragma unroll
                for (int bj = 0; bj < 2; ++bj) *(u32x4*)(rp + bj * 128) = pack8(acc[ai][bj][m][0], acc[ai][bj][m][1]); }
    }
};

DI void transpose_cvt(const float* W, bf16_t* WT, int K, int N, int tid) {
    const long total = (long)N * (K / 8);
    for (long i = (long)blockIdx.x * 512 + tid; i < total; i += (long)gridDim.x * 512) {
        const int n = (int)(i % N), kc = (int)(i / N);
        const float* w = W + (size_t)(kc * 8) * N + n;
        float v[8];
#pragma unroll
        for (int j = 0; j < 8; ++j) v[j] = w[(size_t)j * N];
        u32x4 o; o.x = pk2(v[0], v[1]); o.y = pk2(v[2], v[3]); o.z = pk2(v[4], v[5]); o.w = pk2(v[6], v[7]);
        *(u32x4*)(WT + (size_t)n * K + kc * 8) = o;
    }
}
DI void phase_prep(const Params& p, int tid) {
    const long gtid = (long)blockIdx.x * 512 + tid, gsz = (long)gridDim.x * 512;
    for (long i = gtid; i < 2L * NW * 128; i += gsz) {
        const int n = (int)(i % NW), kc = (int)((i / NW) % 128), l = (int)(i / ((long)NW * 128));
        int src; float sc = 1.f;
        if (n < NNORM) {
            if (n < 1024) src = 3088 + n;
            else if (n < 2048) { src = 4112 + (n - 1024); sc = 0.0625f; }
            else if (n < 2560) { src = n - 2048; sc = 0.08838834764831845f; }
            else if (n < 3072) src = 512 + (n - 2560);
            else if (n < 4096) src = 2048 + (n - 3072);
            else if (n < 5120) src = 6160 + (n - 4096);
            else if (n < 6144) src = 7184 + (n - 5120);
            else src = 8208 + (n - 6144);
        } else {
            const int m = n - NNORM;
            if (m < 1024) src = 1024 + m;
            else src = 5136 + (m - 1024);
        }
        const float* w = p.w_in + (size_t)l * DM * NIN + (size_t)(kc * 8) * NIN + src;
        float v[8];
#pragma unroll
        for (int j = 0; j < 8; ++j) v[j] = w[(size_t)j * NIN] * sc;
        u32x4 o; o.x = pk2(v[0], v[1]); o.y = pk2(v[2], v[3]); o.z = pk2(v[4], v[5]); o.w = pk2(v[6], v[7]);
        *(u32x4*)(p.WinT + ((size_t)l * NW + n) * DM + kc * 8) = o;
    }
    for (int l = 0; l < 2; ++l) {
        transpose_cvt(p.w_o + (size_t)l * DM * DM, p.WoT + (size_t)l * DM * DM, DM, DM, tid);
        transpose_cvt(p.w_up + (size_t)l * DM * NUP, p.WupT + (size_t)l * NUP * DM, DM, NUP, tid);
        transpose_cvt(p.w_down + (size_t)l * DFF * DM, p.WdT + (size_t)l * DM * DFF, DFF, DM, tid);
    }
    for (long i = gtid; i < 2L * 16 * 1024; i += gsz) {
        const int k = (int)(i & 1023), gi = (int)((i >> 10) & 15), l = (int)(i >> 14);
        p.WgT[i] = (bf16_t)f2bf(p.w_in[(size_t)l * DM * NIN + (size_t)k * NIN + 3072 + gi]);
    }
    for (long i = gtid; i < 4096L * 128; i += gsz) {
        const int pos = (int)(i >> 7), j = (int)(i & 127);
        const double inv = pow(10000.0, -(double)j / 128.0);
        const double ang = (double)pos * inv;
        const float c = (float)cos(ang), s = (float)sin(ang);
        p.cosT[i] = c; p.sinT[i] = s;
    }
}

DI void phase_ln(const void* srcv, const int srcmode, const bf16_t* xres,
                 const float* g, const float* b, float* dstf, bf16_t* dstb, int ntok, int tid,
                 unsigned char* smem, const float* wg, const float* bias16, float* gpre) {
    (void)smem; (void)wg; (void)bias16; (void)gpre;
    const int wid = tid >> 6, lane = tid & 63;
    const int rstride = gridDim.x * 8;
    f32x4 gvv[2][2], bvv[2][2];
#pragma unroll
    for (int q = 0; q < 2; ++q)
#pragma unroll
        for (int h = 0; h < 2; ++h) { gvv[q][h] = *(const f32x4*)(g + q * 512 + lane * 8 + h * 4); bvv[q][h] = *(const f32x4*)(b + q * 512 + lane * 8 + h * 4); }
    u32x4 na[2], nb[2];
#define LN_LOAD(r_) do { _Pragma("unroll") for (int q = 0; q < 2; ++q) { \
        if (srcmode) { na[q] = *(const u32x4*)((const bf16_t*)srcv + (size_t)(r_) * DM + q * 512 + lane * 8); nb[q] = *(const u32x4*)(xres + (size_t)(r_) * DM + q * 512 + lane * 8); } \
        else { na[q] = *(const u32x4*)((const float*)srcv + (size_t)(r_) * DM + q * 512 + lane * 8); nb[q] = *(const u32x4*)((const float*)srcv + (size_t)(r_) * DM + q * 512 + lane * 8 + 4); } } } while (0)
    {
        const int r0 = blockIdx.x * 8 + wid;
        if (r0 < ntok) LN_LOAD(r0);
    }
    for (int row = blockIdx.x * 8 + wid; row < ntok; row += rstride) {
        f32x4 v[2][2]; float s = 0.f;
#pragma unroll
        for (int q = 0; q < 2; ++q) {
            const u32x4 ra = na[q], rb = nb[q];
            if (srcmode) {
                v[q][0] = (f32x4){bflo(ra.x) + ALPHA * bflo(rb.x), bfhi(ra.x) + ALPHA * bfhi(rb.x), bflo(ra.y) + ALPHA * bflo(rb.y), bfhi(ra.y) + ALPHA * bfhi(rb.y)};
                v[q][1] = (f32x4){bflo(ra.z) + ALPHA * bflo(rb.z), bfhi(ra.z) + ALPHA * bfhi(rb.z), bflo(ra.w) + ALPHA * bflo(rb.w), bfhi(ra.w) + ALPHA * bfhi(rb.w)};
            } else { v[q][0] = __builtin_bit_cast(f32x4, ra); v[q][1] = __builtin_bit_cast(f32x4, rb); }
#pragma unroll
            for (int h = 0; h < 2; ++h) s += v[q][h][0] + v[q][h][1] + v[q][h][2] + v[q][h][3];
        }
        if (row + rstride < ntok) LN_LOAD(row + rstride);
#pragma unroll
        for (int o = 32; o >= 1; o >>= 1) s += __shfl_xor(s, o);
        const float mu = s * (1.f / 1024.f);
        float ss = 0.f;
#pragma unroll
        for (int q = 0; q < 2; ++q)
#pragma unroll
            for (int h = 0; h < 2; ++h) { v[q][h] = v[q][h] - mu; ss += v[q][h][0] * v[q][h][0] + v[q][h][1] * v[q][h][1] + v[q][h][2] * v[q][h][2] + v[q][h][3] * v[q][h][3]; }
#pragma unroll
        for (int o = 32; o >= 1; o >>= 1) ss += __shfl_xor(ss, o);
        const float rstd = rsqrtf(ss * (1.f / 1024.f) + LN_EPS);
#pragma unroll
        for (int q = 0; q < 2; ++q) {
            const f32x4 y0 = v[q][0] * rstd * gvv[q][0] + bvv[q][0], y1 = v[q][1] * rstd * gvv[q][1] + bvv[q][1];
            if (dstf) { *(f32x4*)(dstf + (size_t)row * DM + q * 512 + lane * 8) = y0; *(f32x4*)(dstf + (size_t)row * DM + q * 512 + lane * 8 + 4) = y1; }
            if (dstb) *(u32x4*)(dstb + (size_t)row * DM + q * 512 + lane * 8) = pack8(y0, y1);
        }
    }
#undef LN_LOAD
}

DI void phase_gscan(const Params& p, const float* gpre, int nchunks, int tid) {
    const int wid = tid >> 6, lane = tid & 63;
    const int tstride = gridDim.x * 8, ntask = nchunks * 8;
    float ni0 = 0.f, nf0 = 0.f, ni1 = 0.f, nf1 = 0.f;
#define GS_LOAD(task_) do { const int ch_ = (task_) >> 3, dir_ = ((task_) >> 2) & 1, head_ = (task_) & 3; \
        const int q0_ = dir_ ? 127 - 2 * lane : 2 * lane, q1_ = dir_ ? 126 - 2 * lane : 2 * lane + 1; \
        const float* r0_ = gpre + (size_t)(ch_ * 128 + q0_) * 16 + dir_ * 8 + head_; const float* r1_ = gpre + (size_t)(ch_ * 128 + q1_) * 16 + dir_ * 8 + head_; \
        ni0 = r0_[0]; nf0 = r0_[4]; ni1 = r1_[0]; nf1 = r1_[4]; } while (0)
    { const int t0 = blockIdx.x * 8 + wid; if (t0 < ntask) GS_LOAD(t0); }
    for (int task = blockIdx.x * 8 + wid; task < ntask; task += tstride) {
        const int ch = task >> 3, dir = (task >> 2) & 1, head = task & 3;
        const int p0 = dir ? 127 - 2 * lane : 2 * lane, p1 = dir ? 126 - 2 * lane : 2 * lane + 1;
        const float i0 = ni0, f0 = nf0, i1 = ni1, f1 = nf1;
        if (task + tstride < ntask) GS_LOAD(task + tstride);
        const float l0 = fminf(f0, 0.f) - log1pf(__expf(-fabsf(f0))), l1 = fminf(f1, 0.f) - log1pf(__expf(-fabsf(f1)));
        const float pair = l0 + l1;
        float inc = pair;
#pragma unroll
        for (int d = 1; d < 64; d <<= 1) { const float t = __shfl_up(inc, d); if (lane >= d) inc += t; }
        const float exc = inc - pair;
        const float c0 = exc + l0, c1 = exc + pair;
        const float b0 = i0 - c0, b1 = i1 - c1;
        float mx = fmaxf(b0, b1);
#pragma unroll
        for (int d = 1; d < 64; d <<= 1) { const float t = __shfl_up(mx, d); if (lane >= d) mx = fmaxf(mx, t); }
        float mexc = __shfl_up(mx, 1); if (lane == 0) mexc = -3.0e38f;
        const float pm0 = fmaxf(mexc, b0), pm1 = fmaxf(pm0, b1);
        float* gp = p.gates + ((size_t)(ch * 2 + dir) * 4 + head) * 384;
        gp[p0] = b0; gp[128 + p0] = pm0; gp[256 + p0] = c0;
        gp[p1] = b1; gp[128 + p1] = pm1; gp[256 + p1] = c1;
    }
#undef GS_LOAD
}

DI void phase_gates2(const Params& p, unsigned char* smem, int layer, const bf16_t* xin, int nchunks, int tid) {
    const int wid = tid >> 6, lane = tid & 63, r16 = lane & 15, kq = lane >> 4;
    float* pre = (float*)smem;
    const bf16_t* wgt = p.WgT + (size_t)layer * 16 * DM;
    for (int ch = blockIdx.x; ch < nchunks; ch += gridDim.x) {
        {
            const bf16_t* ap = xin + (size_t)(ch * 128 + wid * 16 + r16) * DM + kq * 8;
            const bf16_t* bp = wgt + (size_t)r16 * DM + kq * 8;
            f32x4 acc = {0.f, 0.f, 0.f, 0.f};
#pragma unroll 8
            for (int ks = 0; ks < 32; ++ks) {
                const bf16x8 av = *(const bf16x8*)(ap + ks * 32), bv = *(const bf16x8*)(bp + ks * 32);
                acc = __builtin_amdgcn_mfma_f32_16x16x32_bf16(av, bv, acc, 0, 0, 0);
            }
            const float bb = p.b_if[layer * 16 + r16];
#pragma unroll
            for (int r = 0; r < 4; ++r) pre[(wid * 16 + kq * 4 + r) * 17 + r16] = acc[r] + bb;
        }
        __syncthreads();
        {
            const int dir = wid >> 2, head = wid & 3;
            const int p0 = dir ? 127 - 2 * lane : 2 * lane, p1 = dir ? 126 - 2 * lane : 2 * lane + 1;
            const float i0 = pre[p0 * 17 + dir * 8 + head], f0 = pre[p0 * 17 + dir * 8 + 4 + head];
            const float i1 = pre[p1 * 17 + dir * 8 + head], f1 = pre[p1 * 17 + dir * 8 + 4 + head];
            const float l0 = fminf(f0, 0.f) - log1pf(__expf(-fabsf(f0))), l1 = fminf(f1, 0.f) - log1pf(__expf(-fabsf(f1)));
            const float pair = l0 + l1;
            float inc = pair;
#pragma unroll
            for (int d = 1; d < 64; d <<= 1) { const float t = __shfl_up(inc, d); if (lane >= d) inc += t; }
            const float exc = inc - pair;
            const float c0 = exc + l0, c1 = exc + pair;
            const float b0 = i0 - c0, b1 = i1 - c1;
            float mx = fmaxf(b0, b1);
#pragma unroll
            for (int d = 1; d < 64; d <<= 1) { const float t = __shfl_up(mx, d); if (lane >= d) mx = fmaxf(mx, t); }
            float mexc = __shfl_up(mx, 1); if (lane == 0) mexc = -3.0e38f;
            const float pm0 = fmaxf(mexc, b0), pm1 = fmaxf(pm0, b1);
            float* gp = p.gates + ((size_t)(ch * 2 + dir) * 4 + head) * 384;
            gp[p0] = b0; gp[128 + p0] = pm0; gp[256 + p0] = c0;
            gp[p1] = b1; gp[128 + p1] = pm1; gp[256 + p1] = c1;
        }
        __syncthreads();
    }
}

DI void phase_merge(const Params& p, int layer, int ntok, int tid) {
    const int wid = tid >> 6, lane = tid & 63;
    const int ch0 = lane * 16;
    const int rstride = gridDim.x * 8;
    float gav[16], gbv[16];
#pragma unroll
    for (int j = 0; j < 16; j += 4) {
        const f32x4 t0 = *(const f32x4*)(p.g_a + layer * DM + ch0 + j), t1 = *(const f32x4*)(p.g_b + layer * DM + ch0 + j);
#pragma unroll
        for (int k = 0; k < 4; ++k) { gav[j + k] = t0[k]; gbv[j + k] = t1[k]; }
    }
    u32x4 pre[8][2];
#define MERGE_LOAD(r) do { \
        const u32x4* a0 = (const u32x4*)(p.H0 + (size_t)(r) * DM + ch0); const u32x4* a1 = (const u32x4*)(p.H1 + (size_t)(r) * DM + ch0); \
        const u32x4* b0 = (const u32x4*)(p.H2 + (size_t)(r) * DM + ch0); const u32x4* b1 = (const u32x4*)(p.H3 + (size_t)(r) * DM + ch0); \
        const u32x4* e = (const u32x4*)(p.E + (size_t)(r) * 4096 + ch0); \
        _Pragma("unroll") for (int q = 0; q < 2; ++q) { pre[0][q] = a0[q]; pre[1][q] = a1[q]; pre[2][q] = b0[q]; pre[3][q] = b1[q]; pre[4][q] = e[q]; pre[5][q] = e[128 + q]; pre[6][q] = e[256 + q]; pre[7][q] = e[384 + q]; } } while (0)
    { const int r0 = blockIdx.x * 8 + wid; if (r0 < ntok) MERGE_LOAD(r0); }
    for (int row = blockIdx.x * 8 + wid; row < ntok; row += rstride) {
        float ha[16], hb[16], oa[16], gb[16], ma[16], mb[16];
        {
            u32x4 cur[8][2];
#pragma unroll
            for (int i = 0; i < 8; ++i) { cur[i][0] = pre[i][0]; cur[i][1] = pre[i][1]; }
            if (row + rstride < ntok) MERGE_LOAD(row + rstride);
#pragma unroll
            for (int q = 0; q < 2; ++q) {
                const u32x4 x0 = cur[0][q], x1 = cur[1][q], y0 = cur[2][q], y1 = cur[3][q], eo = cur[4][q], eg = cur[5][q], em = cur[6][q], en = cur[7][q];
#pragma unroll
                for (int j = 0; j < 4; ++j) {
                    ha[q * 8 + 2 * j] = bflo(x0[j]) + bflo(x1[j]); ha[q * 8 + 2 * j + 1] = bfhi(x0[j]) + bfhi(x1[j]);
                    hb[q * 8 + 2 * j] = bflo(y0[j]) + bflo(y1[j]); hb[q * 8 + 2 * j + 1] = bfhi(y0[j]) + bfhi(y1[j]);
                    oa[q * 8 + 2 * j] = bflo(eo[j]); oa[q * 8 + 2 * j + 1] = bfhi(eo[j]);
                    gb[q * 8 + 2 * j] = bflo(eg[j]); gb[q * 8 + 2 * j + 1] = bfhi(eg[j]);
                    ma[q * 8 + 2 * j] = bflo(em[j]); ma[q * 8 + 2 * j + 1] = bfhi(em[j]);
                    mb[q * 8 + 2 * j] = bflo(en[j]); mb[q * 8 + 2 * j + 1] = bfhi(en[j]);
                }
            }
        }
        float sa = 0.f, sb = 0.f;
#pragma unroll
        for (int j = 0; j < 16; ++j) { ha[j] *= sigmoidf_(oa[j]); sa += ha[j]; sb += hb[j]; }
#pragma unroll
        for (int o = 8; o >= 1; o >>= 1) { sa += __shfl_xor(sa, o); sb += __shfl_xor(sb, o); }
        const float mua = sa * (1.f / 256.f), mub = sb * (1.f / 256.f);
        float va = 0.f, vb = 0.f;
#pragma unroll
        for (int j = 0; j < 16; ++j) { ha[j] -= mua; hb[j] -= mub; va += ha[j] * ha[j]; vb += hb[j] * hb[j]; }
#pragma unroll
        for (int o = 8; o >= 1; o >>= 1) { va += __shfl_xor(va, o); vb += __shfl_xor(vb, o); }
        const float ra = rsqrtf(va * (1.f / 256.f) + LN_EPS), rb = rsqrtf(vb * (1.f / 256.f) + LN_EPS);
        unsigned ow[8];
#pragma unroll
        for (int j = 0; j < 16; j += 2) {
            float r[2];
#pragma unroll
            for (int k = 0; k < 2; ++k) {
                const float ya = ha[j + k] * ra * gav[j + k];
                const float yb = hb[j + k] * rb * gbv[j + k] * (gb[j + k] * sigmoidf_(gb[j + k]));
                r[k] = sigmoidf_(ma[j + k]) * ya + sigmoidf_(mb[j + k]) * yb;
            }
            ow[j >> 1] = pk2(r[0], r[1]);
        }
        u32x4* op = (u32x4*)(p.merged + (size_t)row * DM + ch0);
        op[0] = (u32x4){ow[0], ow[1], ow[2], ow[3]}; op[1] = (u32x4){ow[4], ow[5], ow[6], ow[7]};
    }
}

DI float gelu_tanh(float x) {
    const float u = 0.7978845608028654f * (x + 0.044715f * x * x * x);
    const float e = __expf(2.f * u);
    const float th = 1.f - 2.f * frcp(e + 1.f);
    return 0.5f * x * (1.f + th);
}
DI void phase_conv(const Params& p, int layer, int ntok, int S, int tid) {
    const float* cw = p.conv_w + (size_t)layer * 3 * NUP; const float* cbias = p.conv_b + (size_t)layer * NUP;
    const int wid = tid >> 6, lane = tid & 63;
    constexpr int SEG = 16, NCW = 11;
    const int ntask = NCW * (ntok / SEG);
    for (int task = blockIdx.x * 8 + wid; task < ntask; task += gridDim.x * 8) {
        const int cwv = task % NCW, seg = task / NCW;
        const int c = (cwv * 64 + lane) * 4;
        const int t0 = seg * SEG, pos0 = t0 % S;
        const f32x4 wv0 = *(const f32x4*)(cw + c), wv1 = *(const f32x4*)(cw + NUP + c), wv2 = *(const f32x4*)(cw + 2 * NUP + c), bv = *(const f32x4*)(cbias + c);
        const f32x4 wg0 = *(const f32x4*)(cw + DFF + c), wg1 = *(const f32x4*)(cw + NUP + DFF + c), wg2 = *(const f32x4*)(cw + 2 * NUP + DFF + c), bg = *(const f32x4*)(cbias + DFF + c);
        const bf16_t* hv = p.hu + (size_t)t0 * NUP + c; const bf16_t* hg = hv + DFF;
        bf16_t* op = p.ff + (size_t)t0 * DFF + c;
        const u32x2 z = {0u, 0u};
        u32x2 rv[SEG + 2], rg[SEG + 2];
        rv[0] = pos0 > 0 ? *(const u32x2*)(hv - NUP) : z; rg[0] = pos0 > 0 ? *(const u32x2*)(hg - NUP) : z;
#pragma unroll
        for (int i = 0; i < SEG; ++i) { rv[i + 1] = *(const u32x2*)(hv + (size_t)i * NUP); rg[i + 1] = *(const u32x2*)(hg + (size_t)i * NUP); }
        { const bool hn = (pos0 + SEG - 1) < S - 1; rv[SEG + 1] = hn ? *(const u32x2*)(hv + (size_t)SEG * NUP) : z; rg[SEG + 1] = hn ? *(const u32x2*)(hg + (size_t)SEG * NUP) : z; }
#pragma unroll
        for (int i = 0; i < SEG; ++i) {
            const u32x2 pv = rv[i], cv = rv[i + 1], nv = rv[i + 2], pg = rg[i], cg = rg[i + 1], ng = rg[i + 2];
            const f32x4 pvf = {bflo(pv.x), bfhi(pv.x), bflo(pv.y), bfhi(pv.y)}, cvf = {bflo(cv.x), bfhi(cv.x), bflo(cv.y), bfhi(cv.y)}, nvf = {bflo(nv.x), bfhi(nv.x), bflo(nv.y), bfhi(nv.y)};
            const f32x4 pgf = {bflo(pg.x), bfhi(pg.x), bflo(pg.y), bfhi(pg.y)}, cgf = {bflo(cg.x), bfhi(cg.x), bflo(cg.y), bfhi(cg.y)}, ngf = {bflo(ng.x), bfhi(ng.x), bflo(ng.y), bfhi(ng.y)};
            const f32x4 val = wv0 * pvf + wv1 * cvf + wv2 * nvf + bv;
            const f32x4 gat = wg0 * pgf + wg1 * cgf + wg2 * ngf + bg;
            u32x2 o; o.x = pk2(gelu_tanh(gat[0]) * val[0], gelu_tanh(gat[1]) * val[1]); o.y = pk2(gelu_tanh(gat[2]) * val[2], gelu_tanh(gat[3]) * val[3]);
            *(u32x2*)(op + (size_t)i * DFF) = o;
        }
    }
}

#define BAR_LDS() do { asm volatile("s_waitcnt lgkmcnt(0)" ::: "memory"); __builtin_amdgcn_s_barrier(); asm volatile("" ::: "memory"); } while (0)
#define BAR_ALL() do { asm volatile("s_waitcnt vmcnt(0) lgkmcnt(0)" ::: "memory"); __builtin_amdgcn_s_barrier(); asm volatile("" ::: "memory"); } while (0)
template <int DK, bool ML>
DI void mixer_item(const int tid_in, unsigned char* smem, int S, int nch, int seq, int head, int dir, int split,
                   const bf16_t* Qg, const bf16_t* Kg, const bf16_t* KTg, const bf16_t* VTg, bf16_t* Hout, const float* gates, float lgv) {
    constexpr unsigned VTW_OFF = ML ? 98304u : 114688u;
    constexpr int KS = DK / 16, NST = DK / 128, NKP = DK * 16 / 512;
    int tid = tid_in; asm volatile("" : "+v"(tid));
    const int wid = __builtin_amdgcn_readfirstlane(tid >> 6), lane = tid & 63, l31 = lane & 31, hh = lane >> 5;
    const int vt = wid >> 2, tb = vt ? 7 - wid : wid;
#define MK_BASES(lo, to) \
    const unsigned l31x = ((lo) >> 4) & 31u, hhx = (lo) >> 9; \
    const unsigned a_ks = (unsigned)(vt * 2 * KS * 1024) + (lo); \
    const unsigned a_vt = (unsigned)(65536 + vt * 8 * 1024) + (lo); \
    const unsigned a_cs = (unsigned)(81920 + vt * KS * 1024) + (lo); \
    const unsigned a_ps = (unsigned)(114688 + tb * 8 * 1024) + (lo); \
    const unsigned a_psw = (unsigned)(114688 + (tb * 8 + vt * 4) * 1024) + l31x * 16 + 8 * hhx; \
    const unsigned a_csw = (unsigned)(81920 + (vt * KS + tb * 2) * 1024) + l31x * 16 + 8 * hhx; \
    const unsigned a_cp = (to); \
    const unsigned a_tv = (unsigned)(147456 + tb * 128) + l31x * 4; \
    const unsigned a_sv = (unsigned)(147456 + vt * 256) + 16 * hhx; \
    const unsigned a_hv = 147456u + hhx * 32; \
    const unsigned a_th = 147456u + ((to) >> 2);
    LAS unsigned char* const L = (LAS unsigned char*)smem;
#define LDSB(addr, off) (L + (addr) + (off))
#define LDG(T, base, off) (*(const T*)((const char*)(base) + (unsigned)(off)))
#define KDMA(Kptr, i) __builtin_amdgcn_global_load_lds((const unsigned*)((const char*)(Kptr) + (unsigned)(tofs + (i) * 8192)), (LAS unsigned*)(L + (unsigned)wid * 1024u + (i) * 8192), 16, 0, 0)
    {
        unsigned lo0 = lane * 16, to0 = tid * 16; asm volatile("" : "+v"(lo0), "+v"(to0));
        MK_BASES(lo0, to0)
        (void)a_ks; (void)a_vt; (void)a_cs; (void)a_ps; (void)a_psw; (void)a_csw; (void)a_tv; (void)a_sv; (void)a_hv;
        for (int i = 0; i < 64 * DK * 2 / 16 / 512; ++i) *(LAS u32x4*)LDSB(a_cp, 81920 + i * 8192) = (u32x4){0u, 0u, 0u, 0u};
        if (tid < 128) *(LAS float*)LDSB(a_th, 7 * 512) = 0.f;
        if (ML) {
#pragma unroll
            for (int i = 0; i < 3; ++i) {
                const unsigned ones = (i == 0 && (lo0 & (31u * 16u)) == 0u) ? 0x3F803F80u : 0u;
                *(LAS u32x4*)LDSB(a_cp, 32768 + i * 8192) = (u32x4){ones, ones, ones, ones};
            }
        }
    }
    f32x16 stC[NST];
    f32x16 stX;
#pragma unroll
    for (int r = 0; r < 16; ++r) stX[r] = 0.f;
#pragma unroll
    for (int i = 0; i < NST; ++i)
#pragma unroll
        for (int r = 0; r < 16; ++r) stC[i][r] = 0.f;
    float m = 0.f;
    const int last = dir ? 0 : 127;
    const int c0 = dir ? nch - 1 : 0;
    const size_t blk0 = ((size_t)seq * nch + c0) * 4 + head;
    bf16x8 qf[KS];
    u32x4 vtr[2];
    u32x4 kst[NKP];
    bf16x8 qfn[KS];
    float g_b = 0.f, g_pm = 0.f, g_cb = 0.f, g_pml = 0.f, g_cbl = 0.f;
    {
        unsigned lofs = lane * 16, tofs = tid * 16; asm volatile("" : "+v"(lofs), "+v"(tofs));
        const bf16_t* Kf = Kg + blk0 * (size_t)(128 * DK);
        if (ML) {
#pragma unroll
            for (int i = 0; i < NKP; ++i) kst[i] = LDG(u32x4, Kf, tofs + i * 8192);
        } else {
#pragma unroll
            for (int i = 0; i < NKP; ++i) KDMA(Kf, i);
        }
        const bf16_t* Qf = Qg + blk0 * (size_t)(128 * DK);
#pragma unroll
        for (int ks = 0; ks < KS; ++ks) qf[ks] = LDG(bf16x8, Qf + tb * KS * 512, lofs + ks * 1024);
        const bf16_t* VTf = VTg + blk0 * (size_t)(256 * 128) + split * (2 * 8 * 512);
#pragma unroll
        for (int i = 0; i < 2; ++i) vtr[i] = LDG(u32x4, VTf, tofs + i * 8192);
        if (ML) {
            const float* gp = gates + (((size_t)seq * nch + c0) * 2 + dir) * 4 * 384 + head * 384;
            g_pml = gp[128 + last]; g_cbl = gp[256 + last];
            if (tid < 128) { g_b = gp[tid]; g_pm = gp[128 + tid]; g_cb = gp[256 + tid]; }
        }
    }
    for (int ci = 0; ci < nch; ++ci) {
        const int c = dir ? nch - 1 - ci : ci;
        const bool has_next = ci + 1 < nch;
        unsigned lofs = lane * 16, tofs = tid * 16; asm volatile("" : "+v"(lofs), "+v"(tofs));
        float lgl = lgv; asm volatile("" : "+v"(lgl));
        const float rstep = ML ? 1.f : __expf(dir ? lgl : -lgl);
        MK_BASES(lofs, tofs)
        const int cn = dir ? c - 1 : c + 1;
        const size_t blk = ((size_t)seq * nch + c) * 4 + head;
        const size_t blkn = ((size_t)seq * nch + (has_next ? cn : c)) * 4 + head;
        const bf16_t* KTf = KTg + blk * (size_t)(DK * 128);
        const bf16_t* Kfn = Kg + blkn * (size_t)(128 * DK);
        if (ML) {
#pragma unroll
            for (int i = 0; i < NKP; ++i) *(LAS u32x4*)LDSB(a_cp, i * 8192) = kst[i];
        }
#pragma unroll
        for (int i = 0; i < 2; ++i) *(LAS u32x4*)LDSB(a_cp, 65536 + i * 8192) = vtr[i];
        float dec, m_new = 0.f;
        if (ML) {
            const float Ml = fmaxf(m, g_pml);
            dec = __expf(m - Ml); m_new = g_cbl + Ml;
            if (tid < 128) {
                const float M = fmaxf(m, g_pm);
                *(LAS float*)LDSB(a_th, 0) = g_b * 1.44269504089f; *(LAS float*)LDSB(a_th, 512) = M * 1.44269504089f; *(LAS float*)LDSB(a_th, 1024) = __expf(m - M);
                *(LAS float*)LDSB(a_th, 1536) = __expf(-g_cb - M); *(LAS float*)LDSB(a_th, 2048) = __expf(g_b - Ml); *(LAS float*)LDSB(a_th, 2560) = 0.f;
            }
        } else {
            dec = __expf(lgv * 128.f);
            if (ci == 0 && tid < 128) { *(LAS float*)LDSB(a_th, 1024) = __expf(lgv * (float)(dir ? (128 - tid) : (tid + 1))); *(LAS float*)LDSB(a_th, 2048) = __expf(lgv * (float)(dir ? tid : (127 - tid))); }
        }
        auto do_d0 = [&]() {
#pragma unroll
        for (int i = 0; i < 2; ++i) {
            const unsigned pidx = (unsigned)i * 512u + (tofs >> 4);
            const unsigned s0 = ((pidx >> 6) & 7u) * 16u + ((pidx >> 5) & 1u) * 8u;
            const u32x4 vv = *(const LAS u32x4*)LDSB(a_cp, 65536 + i * 8192);
            const f32x4 w0 = *(const LAS f32x4*)(L + 147456u + 4u * 512u + s0 * 4u), w1 = *(const LAS f32x4*)(L + 147456u + 4u * 512u + s0 * 4u + 16u);
            u32x4 o;
            o.x = pk2(bflo(vv.x) * w0[0], bfhi(vv.x) * w0[1]); o.y = pk2(bflo(vv.y) * w0[2], bfhi(vv.y) * w0[3]);
            o.z = pk2(bflo(vv.z) * w1[0], bfhi(vv.z) * w1[1]); o.w = pk2(bflo(vv.w) * w1[2], bfhi(vv.w) * w1[3]);
            *(LAS u32x4*)LDSB(a_cp, VTW_OFF + i * 8192) = o;
        }
        if (ML && tid < 16) {
            const unsigned s0 = (unsigned)(tid >> 1) * 16u + (unsigned)(tid & 1) * 8u;
            const f32x4 w0 = *(const LAS f32x4*)(L + 147456u + 4u * 512u + s0 * 4u), w1 = *(const LAS f32x4*)(L + 147456u + 4u * 512u + s0 * 4u + 16u);
            u32x4 o; o.x = pk2(w0[0], w0[1]); o.y = pk2(w0[2], w0[3]); o.z = pk2(w1[0], w1[1]); o.w = pk2(w1[2], w1[3]);
            *(LAS u32x4*)(L + 40960u + ((unsigned)(tid >> 1) * 64u + 32u * (unsigned)(tid & 1)) * 16u) = o;
        }
        };
        BAR_ALL();
        if (ML) do_d0();
        {
            float rsp = 0.f;
            const int t = tb * 32 + (int)l31x;
            const float Mtt = ML ? *(const LAS float*)LDSB(a_tv, 512) : 0.f;
#pragma unroll
            for (int sbi = 0; sbi < 2; ++sbi) {
                const int sb = vt * 2 + sbi;
                if (dir ? (sb < tb) : (sb > tb)) continue;
                f32x16 acc;
#pragma unroll
                for (int r = 0; r < 16; ++r) acc[r] = 0.f;
                {
                    bf16x8 fb[2][4];
#pragma unroll
                    for (int j = 0; j < 4; ++j) fb[0][j] = *(const LAS bf16x8*)LDSB(a_ks, (sbi * KS + j) * 1024);
#pragma unroll
                    for (int g = 0; g < KS / 4; ++g) {
                        if (g + 1 < KS / 4) {
#pragma unroll
                            for (int j = 0; j < 4; ++j) fb[(g + 1) & 1][j] = *(const LAS bf16x8*)LDSB(a_ks, (sbi * KS + (g + 1) * 4 + j) * 1024);
                        }
                        __builtin_amdgcn_sched_barrier(0);
#pragma unroll
                        for (int j = 0; j < 4; ++j) acc = MFMA32(fb[g & 1][j], qf[g * 4 + j], acc);
                        __builtin_amdgcn_sched_barrier(0);
                    }
                }
                const int mb = dir ? (t - sb * 32 - 4 * (int)hhx) : (sb * 32 + 4 * (int)hhx - t);
                float wk = 0.f, wr = 0.f;
                if (!ML) { wk = __expf(-lgl * (float)mb); wr = rstep; }
#pragma unroll
                for (int q = 0; q < 4; ++q) {
                    float v[4];
                    f32x4 bs4 = {0.f, 0.f, 0.f, 0.f};
                    if (ML) bs4 = *(const LAS f32x4*)LDSB(a_sv, (sbi * 32 + 8 * q) * 4);
#pragma unroll
                    for (int jj = 0; jj < 4; ++jj) {
                        const int k = 8 * q + jj;
                        const bool ok = mb <= (dir ? k : -k);
                        const float w = ML ? __builtin_amdgcn_exp2f(bs4[jj] - Mtt) : wk;
                        v[jj] = ok ? acc[q * 4 + jj] * w : 0.f;
                        rsp += v[jj];
                        if (!ML) wk *= wr;
                    }
                    if (!ML) { wk *= wr; wk *= wr; wk *= wr; wk *= wr; }
                    u32x2 o; o.x = pk2(v[0], v[1]); o.y = pk2(v[2], v[3]);
                    *(LAS u32x2*)LDSB(a_psw, (sbi * 2 + (q >> 1)) * 1024 + (q & 1) * 512) = o;
                }
            }
            (void)rsp;
        }
        BAR_LDS();
        if (has_next) {
            if (ML) {
#pragma unroll
                for (int i = 0; i < NKP; ++i) kst[i] = LDG(u32x4, Kfn, tofs + i * 8192);
                const bf16_t* Qfn = Qg + blkn * (size_t)(128 * DK);
#pragma unroll
                for (int ks = 0; ks < KS; ++ks) qfn[ks] = LDG(bf16x8, Qfn + tb * KS * 512, lofs + ks * 1024);
                const bf16_t* VTfn = VTg + blkn * (size_t)(256 * 128) + split * (2 * 8 * 512);
#pragma unroll
                for (int i = 0; i < 2; ++i) vtr[i] = LDG(u32x4, VTfn, tofs + i * 8192);
                const float* gp = gates + (((size_t)seq * nch + cn) * 2 + dir) * 4 * 384 + head * 384;
                g_pml = gp[128 + last]; g_cbl = gp[256 + last];
                if (tid < 128) { g_b = gp[tid]; g_pm = gp[128 + tid]; g_cb = gp[256 + tid]; }
            } else {
#pragma unroll
                for (int i = 0; i < NKP; ++i) KDMA(Kfn, i);
            }
        }
        bf16x8 kt[8];
        {
            f32x16 a1, a2;
#pragma unroll
            for (int r = 0; r < 16; ++r) { a1[r] = 0.f; a2[r] = 0.f; }
            f32x16 a1x, a2x;
#pragma unroll
            for (int r = 0; r < 16; ++r) { a1x[r] = 0.f; a2x[r] = 0.f; }
            {
#pragma unroll
                for (int g = 0; g < 4; ++g) {
                    if (dir ? (g < tb) : (g > tb)) continue;
                    const bf16x8 fa0 = *(const LAS bf16x8*)LDSB(a_vt, (g * 2) * 1024), fa1 = *(const LAS bf16x8*)LDSB(a_vt, (g * 2 + 1) * 1024);
                    const bf16x8 fp0 = *(const LAS bf16x8*)LDSB(a_ps, (g * 2) * 1024), fp1 = *(const LAS bf16x8*)LDSB(a_ps, (g * 2 + 1) * 1024);
                    a1 = MFMA32(fa0, fp0, a1); a1 = MFMA32(fa1, fp1, a1);
                    if (ML) {
                        const bf16x8 fx0 = *(const LAS bf16x8*)(L + lofs + 32768u + (g * 2) * 1024), fx1 = *(const LAS bf16x8*)(L + lofs + 32768u + (g * 2 + 1) * 1024);
                        a1x = MFMA32(fx0, fp0, a1x); a1x = MFMA32(fx1, fp1, a1x);
                    }
                }
                bf16x8 fc[2][4];
#pragma unroll
                for (int j = 0; j < 4; ++j) fc[0][j] = *(const LAS bf16x8*)LDSB(a_cs, j * 1024);
#pragma unroll
                for (int g = 0; g < KS / 4; ++g) {
                    if (g + 1 < KS / 4) {
#pragma unroll
                        for (int j = 0; j < 4; ++j) fc[(g + 1) & 1][j] = *(const LAS bf16x8*)LDSB(a_cs, ((g + 1) * 4 + j) * 1024);
                    }
                    __builtin_amdgcn_sched_barrier(0);
#pragma unroll
                    for (int j = 0; j < 4; ++j) a2 = MFMA32(fc[g & 1][j], qf[g * 4 + j], a2);
                    __builtin_amdgcn_sched_barrier(0);
                }
            }
            if (ML) {
#pragma unroll
                for (int ks = 0; ks < KS; ++ks) { const bf16x8 fcx = *(const LAS bf16x8*)(L + lofs + 49152u + ks * 1024); a2x = MFMA32(fcx, qf[ks], a2x); }
            }
#pragma unroll
            for (int ks = 0; ks < 8; ++ks) kt[ks] = LDG(bf16x8, KTf + tb * 8 * 512, lofs + ks * 1024);
            const int t = tb * 32 + (int)l31x; const float wi = *(const LAS float*)LDSB(a_tv, 2 * 512); float inv = 1.f;
            if (ML) { const float d0v = a1x[0] + wi * a2x[0]; const float dsw = __shfl_xor(d0v, 32); const float den = hhx ? dsw : d0v; inv = frcp(fmaxf(fabsf(den), *(const LAS float*)LDSB(a_tv, 3 * 512))); }
            bf16_t* hp = Hout + ((size_t)seq * S + (size_t)c * 128 + t) * DM + head * 256 + split * 64 + vt * 32;
            u32x2 oq[4];
#pragma unroll
            for (int q = 0; q < 4; ++q) {
                oq[q].x = pk2((a1[q * 4] + wi * a2[q * 4]) * inv, (a1[q * 4 + 1] + wi * a2[q * 4 + 1]) * inv);
                oq[q].y = pk2((a1[q * 4 + 2] + wi * a2[q * 4 + 2]) * inv, (a1[q * 4 + 3] + wi * a2[q * 4 + 3]) * inv);
            }
#pragma unroll
            for (int pr = 0; pr < 2; ++pr) {
                const u32x2 keep = hhx ? oq[2 * pr + 1] : oq[2 * pr];
                const u32x2 send = hhx ? oq[2 * pr] : oq[2 * pr + 1];
                u32x2 recv; recv.x = (unsigned)__shfl_xor((int)send.x, 32); recv.y = (unsigned)__shfl_xor((int)send.y, 32);
                const u32x4 w = hhx ? (u32x4){recv.x, recv.y, keep.x, keep.y} : (u32x4){keep.x, keep.y, recv.x, recv.y};
                *(u32x4*)(hp + 8 * (2 * pr + (int)hhx)) = w;
            }
        }
        BAR_LDS();
        if (!ML && has_next) {
            const bf16_t* VTfn = VTg + blkn * (size_t)(256 * 128) + split * (2 * 8 * 512);
#pragma unroll
            for (int i = 0; i < 2; ++i) vtr[i] = LDG(u32x4, VTfn, tofs + i * 8192);
        }
        if (!ML) { do_d0(); BAR_LDS(); }
        bf16x8 fv[8];
#pragma unroll
        for (int ks = 0; ks < 8; ++ks) fv[ks] = *(const LAS bf16x8*)LDSB(a_vt, (VTW_OFF - 65536u) + ks * 1024);
#pragma unroll
        for (int i = 0; i < NST; ++i) {
            bf16x8 ktn[8];
            if (i + 1 < NST) {
#pragma unroll
                for (int ks = 0; ks < 8; ++ks) ktn[ks] = LDG(bf16x8, KTf + (tb + 4 * (i + 1)) * 8 * 512, lofs + ks * 1024);
            }
            if (ML && vt == 0) {
#pragma unroll
                for (int r = 0; r < 16; ++r) stX[r] *= dec;
#pragma unroll
                for (int ks = 0; ks < 8; ++ks) { const bf16x8 fw = *(const LAS bf16x8*)(L + lofs + 40960u + ks * 1024); stX = MFMA32(kt[ks], fw, stX); }
#pragma unroll
                for (int q = 0; q < 4; ++q) {
                    u32x2 o; o.x = pk2(stX[q * 4], stX[q * 4 + 1]); o.y = pk2(stX[q * 4 + 2], stX[q * 4 + 3]);
                    *(LAS u32x2*)(L + 49152u + (unsigned)((tb * 2 + (q >> 1)) * 1024 + (q & 1) * 512) + l31x * 16u + 8u * hhx) = o;
                }
            }
#pragma unroll
            for (int r = 0; r < 16; ++r) stC[i][r] *= dec;
            __builtin_amdgcn_sched_barrier(0);
#pragma unroll
            for (int ks = 0; ks < 8; ++ks) stC[i] = MFMA32(kt[ks], fv[ks], stC[i]);
            __builtin_amdgcn_sched_barrier(0);
#pragma unroll
            for (int q = 0; q < 4; ++q) {
                u32x2 o; o.x = pk2(stC[i][q * 4], stC[i][q * 4 + 1]); o.y = pk2(stC[i][q * 4 + 2], stC[i][q * 4 + 3]);
                *(LAS u32x2*)LDSB(a_csw, (8 * i + (q >> 1)) * 1024 + (q & 1) * 512) = o;
            }
            if (i + 1 < NST) {
#pragma unroll
                for (int ks = 0; ks < 8; ++ks) kt[ks] = ktn[ks];
            }
            if (NST > 1 && i == 0 && has_next) {
                const bf16_t* Qfn = Qg + blkn * (size_t)(128 * DK);
#pragma unroll
                for (int ks = 0; ks < KS; ++ks) qf[ks] = LDG(bf16x8, Qfn + tb * KS * 512, lofs + ks * 1024);
            }
        }
        if (ML && has_next) {
#pragma unroll
            for (int ks = 0; ks < KS; ++ks) qf[ks] = qfn[ks];
        }
        if (ML) m = m_new;
        BAR_LDS();
    }
#undef LDSB
#undef KDMA
#undef LDG
#undef MK_BASES
}

DI void phase_mixer(const Params& p, unsigned char* smem, int layer, int S, int nseq, int tid) {
    const int nch = S / 128, NI = nseq * 32;
    for (int it = blockIdx.x; it < 2 * NI; it += gridDim.x) {
        const int mixer = it / NI, r = it % NI;
        const int head = r & 3, dir = (r >> 2) & 1, split = (r >> 3) & 3, seq = r >> 5;
        if (mixer == 0) mixer_item<256, false>(tid, smem, S, nch, seq, head, dir, split, p.Qb, p.Kb, p.KbT, p.VbT, dir ? p.H3 : p.H2, nullptr, p.lg[layer * 8 + dir * 4 + head]);
        else mixer_item<128, true>(tid, smem, S, nch, seq, head, dir, split, p.Qa, p.Ka, p.KaT, p.VaT, dir ? p.H1 : p.H0, p.gates, 0.f);
    }
}


#define XB_TMO      128
#define XB_XCNT(j)  (256  + 64 * (j))
#define XB_XSUB(j)  (1280 + 64 * (j))
#define XB_XGEN(j)  (2304 + 64 * (j))
#define XB_TOP      3328
#define XB_TOPGEN   3392
#define XCD_BAR_WORDS 3456
#define XB_SPIN_CAP (1u << 22)
DI unsigned xb_ld(unsigned* p)              { return __hip_atomic_load(p, __ATOMIC_RELAXED, __HIP_MEMORY_SCOPE_AGENT); }
DI unsigned xb_add(unsigned* p, unsigned v) { return __hip_atomic_fetch_add(p, v, __ATOMIC_RELAXED, __HIP_MEMORY_SCOPE_AGENT); }
DI unsigned xb_xcc_id() { return (unsigned)__builtin_amdgcn_s_getreg((3 << 11) | 20) & 0xFu; }
#define XB_SPIN(cond, bar) do { unsigned _sp = 0; while (cond) { __builtin_amdgcn_s_sleep(1); \
    if ((++_sp & 255u) == 0u) { if (xb_ld(&(bar)[XB_TMO])) break; if (_sp > XB_SPIN_CAP) { atomicAdd(&(bar)[XB_TMO], 1u); break; } } } } while (0)
struct XcdBarrier { unsigned* bar; unsigned x; volatile LAS unsigned* st; };
DI XcdBarrier xcd_barrier_post(unsigned* bar, volatile LAS unsigned* st, int tid) {
    XcdBarrier b; b.bar = bar; b.x = xb_xcc_id(); b.st = st;
    if (tid == 0) (void)xb_add(&bar[XB_XCNT(b.x)], 1u);
    return b;
}
DI void xcd_barrier_complete(unsigned* bar, unsigned x, unsigned& nloc, unsigned& nx) {
    const unsigned G = gridDim.x * gridDim.y * gridDim.z;
    unsigned sum, cnt, mine, sp = 0u;
    for (;;) {
        sum = 0u; cnt = 0u; mine = 0u;
#pragma unroll
        for (unsigned j = 0; j < 16; ++j) { const unsigned c = xb_ld(&bar[XB_XCNT(j)]); sum += c; cnt += (c > 0u) ? 1u : 0u; mine = (j == x) ? c : mine; }
        if (sum == G) break;
        __builtin_amdgcn_s_sleep(1);
        if ((++sp & 255u) == 0u) { if (xb_ld(&bar[XB_TMO])) break; if (sp > XB_SPIN_CAP) { atomicAdd(&bar[XB_TMO], 1u); break; } }
    }
    nloc = mine > 0u ? mine : 1u; nx = cnt > 0u ? cnt : 1u;
}
DI void xcd_barrier(const XcdBarrier& b, int tid) {
    asm volatile("s_waitcnt vmcnt(0)" ::: "memory");
    __syncthreads();
    if (tid == 0) {
        unsigned* bar = b.bar;
        __builtin_amdgcn_s_waitcnt(0);
        unsigned nloc = b.st[0], nx = b.st[1];
        if (nloc == 0u) { xcd_barrier_complete(bar, b.x, nloc, nx); b.st[0] = nloc; b.st[1] = nx; }
        const unsigned old = xb_add(&bar[XB_XSUB(b.x)], 1u);
        const unsigned gen = old / nloc;
        if (old + 1u == (gen + 1u) * nloc) {
            __builtin_amdgcn_fence(__ATOMIC_RELEASE, "agent");
            asm volatile("s_waitcnt vmcnt(0)" ::: "memory");
            const unsigned og = xb_add(&bar[XB_TOP], 1u);
            const unsigned tg = og / nx;
            if (og + 1u == (tg + 1u) * nx) xb_add(&bar[XB_TOPGEN], 1u);
            else XB_SPIN(xb_ld(&bar[XB_TOPGEN]) == tg, bar);
            __builtin_amdgcn_fence(__ATOMIC_ACQUIRE, "agent");
            xb_add(&bar[XB_XGEN(b.x)], 1u);
            asm volatile("s_waitcnt vmcnt(0)" ::: "memory");
        } else {
            XB_SPIN(xb_ld(&bar[XB_XGEN(b.x)]) == gen, bar);
            __builtin_amdgcn_fence(__ATOMIC_ACQUIRE, "agent");
            asm volatile("s_waitcnt vmcnt(0)" ::: "memory");
        }
    }
    __syncthreads();
}

DI size_t al256(size_t x) { return (x + 255) & ~(size_t)255; }
DI void build_params(Params& p, const KArgs& a, char* w, int G) {
    p.x_prompt = a.in[0]; p.x_sample = a.in[1]; p.ln_in_g = a.in[2]; p.ln_in_b = a.in[3]; p.w_in = a.in[4]; p.b_if = a.in[5]; p.lg = a.in[6]; p.g_a = a.in[7]; p.g_b = a.in[8];
    p.w_o = a.in[9]; p.ln1_g = a.in[10]; p.ln1_b = a.in[11]; p.w_up = a.in[12]; p.conv_w = a.in[13]; p.conv_b = a.in[14]; p.w_down = a.in[15]; p.ln2_g = a.in[16]; p.ln2_b = a.in[17];
    p.out = a.out; p.G = G; p.pad = 0;
    size_t o = 0;
    p.WinT = (bf16_t*)(w + o); o += al256((size_t)2 * NW * DM * 2);
    p.WoT = (bf16_t*)(w + o); o += al256((size_t)2 * DM * DM * 2);
    p.WupT = (bf16_t*)(w + o); o += al256((size_t)2 * NUP * DM * 2);
    p.WdT = (bf16_t*)(w + o); o += al256((size_t)2 * DM * DFF * 2);
    p.cosT = (float*)(w + o); o += (size_t)4096 * 128 * 4; p.sinT = (float*)(w + o); o += (size_t)4096 * 128 * 4;
    p.cosTT = (float*)(w + o); o += (size_t)4096 * 128 * 4; p.sinTT = (float*)(w + o); o += (size_t)4096 * 128 * 4;
    p.gates = (float*)(w + o); o += (size_t)G * 96;
    p.gpre = (float*)(w + o); o += (size_t)G * 64;
    p.WgT = (bf16_t*)(w + o); o += 65536;
    char* ubase = w + o;
    const size_t g1 = (size_t)G * 1024;
    p.Qb = (bf16_t*)(w + o); o += 2 * g1; p.Kb = (bf16_t*)(w + o); o += 2 * g1;
    p.Qa = (bf16_t*)(w + o); o += g1; p.Ka = (bf16_t*)(w + o); o += g1;
    p.E = (bf16_t*)(w + o); o += 8 * g1;
    p.KbT = (bf16_t*)(w + o); o += 2 * g1; p.KaT = (bf16_t*)(w + o); o += g1;
    p.VaT = (bf16_t*)(w + o); o += 2 * g1; p.VbT = (bf16_t*)(w + o); o += 2 * g1;
    p.H0 = (bf16_t*)(w + o); o += 2 * g1; p.H1 = (bf16_t*)(w + o); o += 2 * g1;
    p.H2 = (bf16_t*)(w + o); o += 2 * g1; p.H3 = (bf16_t*)(w + o); o += 2 * g1;
    p.xb = p.H0; p.merged = (bf16_t*)ubase; p.hu = (bf16_t*)ubase; p.ff = (bf16_t*)(ubase + (size_t)G * NUP * 2);
}
DI void run_phase(const Params& p, unsigned char* smem, int ph, const int tid) {
    const int G = p.G;
    const int g = (ph - 1) / 19, q = (ph - 1) % 19;
    const int T0 = g * G;
    const int S = T0 < TPROMPT ? 2048 : 4096;
    const int nseq = G / S;
    float* xg = p.out + (size_t)T0 * DM;
    bf16_t* xin = (bf16_t*)xg;
    bf16_t* yb = p.H2;
    LAS unsigned char* lds = (LAS unsigned char*)smem;
    if (q == 0) return;
    const int l = (q - 1) / 9, k = (q - 1) % 9;
    pg8::StaticOrder so;
    switch (k) {
    case 0: {
        { pg8::Gemm gm{xin, p.WinT + (size_t)l * NW * DM, G, NNORM, DM}; so.init(gm.M, gm.N, (int)gridDim.x, (int)blockIdx.x); EpiInN e{&p, S, smem}; pg8::gemm_phase(lds, gm, so, e, tid); }
        { pg8::Gemm gm{p.WinT + ((size_t)l * NW + NNORM) * DM, xin, NTR, G, DM}; so.init(gm.M, gm.N, (int)gridDim.x, (int)blockIdx.x); EpiInT e{&p, S}; pg8::gemm_phase(lds, gm, so, e, tid); }
        phase_gates2(p, smem, l, xin, G / 128, tid);
    } break;
    case 1: phase_mixer(p, smem, l, S, nseq, tid); break;
    case 2: phase_merge(p, l, G, tid); break;
    case 3: { pg8::Gemm gm{p.merged, p.WoT + (size_t)l * DM * DM, G, DM, DM}; so.init(gm.M, gm.N, (int)gridDim.x, (int)blockIdx.x); EpiB16 e{yb, DM}; pg8::gemm_phase(lds, gm, so, e, tid); } break;
    case 4: phase_ln(yb, 2, xin, p.ln1_g + l * DM, p.ln1_b + l * DM, nullptr, p.xb, G, tid, smem, nullptr, nullptr, nullptr); break;
    case 5: { pg8::Gemm gm{p.xb, p.WupT + (size_t)l * NUP * DM, G, NUP, DM}; so.init(gm.M, gm.N, (int)gridDim.x, (int)blockIdx.x); EpiB16 e{p.hu, NUP}; pg8::gemm_phase(lds, gm, so, e, tid); } break;
    case 6: phase_conv(p, l, G, S, tid); break;
    case 7: { pg8::Gemm gm{p.ff, p.WdT + (size_t)l * DM * DFF, G, DM, DFF}; so.init(gm.M, gm.N, (int)gridDim.x, (int)blockIdx.x); EpiB16 e{yb, DM}; pg8::gemm_phase(lds, gm, so, e, tid); } break;
    default: {
        const int T1 = T0 + G;
        const int nrep = (l == 1 && T1 < TTOT) ? 2 : 1;
        _Pragma("nounroll") for (int rep = 0; rep < nrep; ++rep) {
            const void* src; const float* gg; const float* bb; float* df; bf16_t* db;
            if (rep == 0) { src = yb; gg = p.ln2_g + l * DM; bb = p.ln2_b + l * DM; df = l == 1 ? xg : nullptr; db = l == 1 ? nullptr : xin; }
            else { src = T1 < TPROMPT ? p.x_prompt + (size_t)T1 * DM : p.x_sample + (size_t)(T1 - TPROMPT) * DM; gg = p.ln_in_g; bb = p.ln_in_b; df = nullptr; db = (bf16_t*)(p.out + (size_t)T1 * DM); }
            phase_ln(src, rep == 0 ? 2 : 0, p.xb, gg, bb, df, db, G, tid, smem, nullptr, nullptr, nullptr);
        }
    } break;
    }
}

__global__ __launch_bounds__(512, 2) void mega(KArgs a, int ph_lo, int ph_hi) {
    extern __shared__ __attribute__((aligned(16))) unsigned char smem[];
    const int wid0 = __builtin_amdgcn_readfirstlane((int)threadIdx.x >> 6);
#define MK_TID() (wid0 * 64 + (int)__builtin_amdgcn_mbcnt_hi(~0u, __builtin_amdgcn_mbcnt_lo(~0u, 0u)))
    const bool multi = ph_hi - ph_lo > 1;
    XcdBarrier xb; xb.bar = a.bar; xb.x = 0; xb.st = (volatile LAS unsigned*)((LAS unsigned char*)smem + 151552);
    if (multi) {
        int tid1 = MK_TID(); asm volatile("" : "+v"(tid1));
        if (tid1 == 0) { xb.st[0] = 0u; xb.st[1] = 0u; }
        __syncthreads();
        xb = xcd_barrier_post(a.bar, xb.st, tid1);
    }
    if (ph_hi < -1000) cg::this_grid().sync();
    if (ph_lo == 0) {
        int tid0 = MK_TID(); asm volatile("" : "+v"(tid0));
        Params p; build_params(p, a, a.ws, a.G);
        phase_prep(p, tid0);
        phase_ln(p.x_prompt, 0, nullptr, p.ln_in_g, p.ln_in_b, nullptr, (bf16_t*)p.out, a.G, tid0, smem, nullptr, nullptr, nullptr);
        ph_lo = 1;
        if (ph_lo < ph_hi) xcd_barrier(xb, tid0);
    }
    for (int ph = ph_lo; ph < ph_hi; ++ph) {
        int wq = wid0; asm volatile("" : "+s"(wq));
        int tid = wq * 64 + (int)__builtin_amdgcn_mbcnt_hi(~0u, __builtin_amdgcn_mbcnt_lo(~0u, 0u)); asm volatile("" : "+v"(tid));
        int G = a.G; char* w = a.ws; asm volatile("" : "+s"(G));
        Params p; build_params(p, a, w, G);
        if ((ph - 1) % 19 == 0) continue;
        run_phase(p, smem, ph, tid);
        if (ph + 1 < ph_hi) xcd_barrier(xb, tid);
    }
}

#ifndef ONE_LAUNCH
#define ONE_LAUNCH 1
#endif

extern "C" void kernel_launch(void* const* d_in, const int* in_sizes, int n_in, void* d_out, int out_size, void* d_ws, size_t ws_size, hipStream_t stream) {
    static int grid = 0;
    if (grid == 0) {
        int dev = 0, cus = 0, per_cu = 0;
        hipGetDevice(&dev);
        hipDeviceGetAttribute(&cus, hipDeviceAttributeMultiprocessorCount, dev);
        hipFuncSetAttribute((const void*)mega, hipFuncAttributeMaxDynamicSharedMemorySize, LDS_BYTES);
        hipOccupancyMaxActiveBlocksPerMultiprocessor(&per_cu, (const void*)mega, 512, LDS_BYTES);
        (void)hipGetLastError();
        if (per_cu < 1) per_cu = 1;
        if (cus <= 0) cus = 256;
        grid = cus;
    }
    KArgs p{};
    for (int i = 0; i < 18; ++i) p.in[i] = (const float*)d_in[i];
    p.out = (float*)d_out; p.ws = (char*)d_ws + 16384; p.bar = (unsigned*)d_ws;
    auto need = [](size_t G) { return (size_t)2 * NW * DM * 2 + (size_t)2 * DM * DM * 2 + (size_t)2 * NUP * DM * 2 + (size_t)2 * DM * DFF * 2 + (size_t)4 * 4096 * 128 * 4 + G * 160 + G * (size_t)(NW) * 2 + G * (size_t)4 * DM * 2 + 4096 + 16384 + 65536; };
    int G = 32768;
    if (need(G) > ws_size) G = 16384;
    p.G = G;
    const int ngroups = TTOT / G;
    const int nph = 1 + ngroups * 19;
#if ONE_LAUNCH
    hipMemsetAsync(d_ws, 0, 16384, stream);
    int lo = 0, hi = nph;
    void* args[] = {&p, &lo, &hi};
    hipError_t e = hipLaunchCooperativeKernel((const void*)mega, dim3(grid), dim3(512), args, LDS_BYTES, stream);
    if (e != hipSuccess) fprintf(stderr, "cooperative launch failed: %s (grid %d)\n", hipGetErrorString(e), grid);
#else
    for (int ph = 0; ph < nph; ++ph) hipLaunchKernelGGL(mega, dim3(grid), dim3(512), LDS_BYTES, stream, p, ph, ph + 1);
#endif
}
```
